# Optimizing an MI355X kernel written in HIP

```python
import math
import jax, jax.numpy as jnp
from jax import lax
import numpy as np

D_MODEL = 1024
BATCH = 16
SEQ = 2048
DEPTH = 1

GLA_HEADS = 4
GLA_DK = 64
GLA_DV = 128
GLA_QK_WIDTH = GLA_HEADS * GLA_DK
GLA_WIDTH = GLA_HEADS * GLA_DV
GATE_RANK = 16
GATE_NORMALIZER = 16.0
CHUNK = 64
CONV_WIDTH = D_MODEL // 2
CONV_GROUPS = 8
CONV_K = 3
MIX_WIDTH = GLA_WIDTH + CONV_WIDTH
D_FF = int(math.ceil(8 * D_MODEL / 3 / 256) * 256)
NORM_EPS = 1e-6

COL_Q = GLA_QK_WIDTH
COL_K = GLA_QK_WIDTH
COL_V = GLA_WIDTH
COL_G = GLA_WIDTH
COL_A = GATE_RANK
COL_CB = CONV_WIDTH
COL_CC = CONV_WIDTH
COL_CH = CONV_WIDTH
IN_COLS = COL_Q + COL_K + COL_V + COL_G + COL_A + COL_CB + COL_CC + COL_CH

kernel_name = "hymba_gla_shortconv_block"


def rmsnorm(x, g):
    xf = x.astype(jnp.float32)
    y = xf * lax.rsqrt(jnp.mean(xf * xf, axis=-1, keepdims=True) + NORM_EPS)
    return (y * g.astype(jnp.float32)).astype(x.dtype)


def gla_chunked(q, k, v, log_a):
    bsz, seq, heads, dk = q.shape
    dv = v.shape[-1]
    n_chunks = seq // CHUNK

    def to_chunks(t):
        return t.astype(jnp.float32).reshape(bsz, n_chunks, CHUNK, heads, t.shape[-1]).transpose(1, 0, 3, 2, 4)

    q, k, v, log_a = to_chunks(q), to_chunks(k), to_chunks(v), to_chunks(log_a)
    b = jnp.cumsum(log_a, axis=-2)
    b_last = b[..., -1:, :]
    q_i = q * jnp.exp(b)
    k_i = k * jnp.exp(-b)
    k_s = k * jnp.exp(b_last - b)

    causal = jnp.tril(jnp.ones((CHUNK, CHUNK), dtype=bool))
    scores = jnp.einsum('nbhck,nbhsk->nbhcs', q_i, k_i)
    scores = jnp.where(causal, scores, 0.0)
    o_intra = jnp.einsum('nbhcs,nbhsv->nbhcv', scores, v)

    chunk_kv = jnp.einsum('nbhsk,nbhsv->nbhkv', k_s, v)
    chunk_decay = jnp.exp(b_last[..., 0, :])

    def step(state, inp):
        dec, kv_c = inp
        return dec[..., None] * state + kv_c, state

    state0 = jnp.zeros((bsz, heads, dk, dv), jnp.float32)
    _, state_prev = lax.scan(step, state0, (chunk_decay, chunk_kv))
    o_inter = jnp.einsum('nbhck,nbhkv->nbhcv', q_i, state_prev)

    o = o_intra + o_inter
    return o.transpose(1, 0, 3, 2, 4).reshape(bsz, seq, heads, dv)


def causal_depthwise_conv(u, w):
    seq = u.shape[1]
    u_pad = jnp.pad(u, ((0, 0), (CONV_K - 1, 0), (0, 0)))
    y = w[0] * u_pad[:, 0:seq]
    for j in range(1, CONV_K):
        y = y + w[j] * u_pad[:, j:j + seq]
    return y


def setup_inputs(seed: int = 0) -> dict:
    key = jax.random.key(seed)
    ks = jax.random.split(key, 16)
    f32 = jnp.float32
    n = lambda k, shape, scale: (jax.random.normal(k, shape, f32) * scale)
    return {
        "x": n(ks[0], (BATCH, SEQ, D_MODEL), 1.0),
        "norm1_g": 1.0 + n(ks[1], (DEPTH, D_MODEL), 0.02),
        "w_in": n(ks[2], (DEPTH, D_MODEL, IN_COLS), D_MODEL ** -0.5),
        "w_gate_up": n(ks[3], (DEPTH, GATE_RANK, GLA_QK_WIDTH), GATE_RANK ** -0.5),
        "b_gate": n(ks[4], (DEPTH, GLA_QK_WIDTH), 0.01),
        "gla_norm_g": 1.0 + n(ks[5], (DEPTH, GLA_DV), 0.02),
        "conv_w": n(ks[6], (DEPTH, CONV_K, CONV_WIDTH), CONV_K ** -0.5),
        "w_out": n(ks[7], (DEPTH, MIX_WIDTH, D_MODEL), MIX_WIDTH ** -0.5),
        "norm2_g": 1.0 + n(ks[8], (DEPTH, D_MODEL), 0.02),
        "w_ffn_gate": n(ks[9], (DEPTH, D_MODEL, D_FF), D_MODEL ** -0.5),
        "w_ffn_up": n(ks[10], (DEPTH, D_MODEL, D_FF), D_MODEL ** -0.5),
        "w_ffn_down": n(ks[11], (DEPTH, D_FF, D_MODEL), D_FF ** -0.5),
        "norm_f_g": 1.0 + n(ks[12], (D_MODEL,), 0.02),
    }


def reference(x, norm1_g, w_in, w_gate_up, b_gate, gla_norm_g, conv_w, w_out,
              norm2_g, w_ffn_gate, w_ffn_up, w_ffn_down, norm_f_g):
    bsz, seq, _ = x.shape
    splits = np.cumsum([COL_Q, COL_K, COL_V, COL_G, COL_A, COL_CB, COL_CC])
    for l in range(DEPTH):
        h = rmsnorm(x, norm1_g[l])
        proj = h @ w_in[l]
        p_q, p_k, p_v, p_g, p_a, c_b, c_c, c_h = jnp.split(proj, splits, axis=-1)

        q = p_q.reshape(bsz, seq, GLA_HEADS, GLA_DK) * (GLA_DK ** -0.5)
        k = p_k.reshape(bsz, seq, GLA_HEADS, GLA_DK)
        v = p_v.reshape(bsz, seq, GLA_HEADS, GLA_DV)
        gate_logits = (p_a @ w_gate_up[l] + b_gate[l]).astype(jnp.float32)
        log_a = (jax.nn.log_sigmoid(gate_logits) / GATE_NORMALIZER).reshape(bsz, seq, GLA_HEADS, GLA_DK)
        o = gla_chunked(q, k, v, log_a)
        o = rmsnorm(o, gla_norm_g[l]).astype(x.dtype)
        o = o * jax.nn.silu(p_g.reshape(bsz, seq, GLA_HEADS, GLA_DV))
        o_gla = o.reshape(bsz, seq, GLA_WIDTH)

        u = c_c * c_h
        o_conv = c_b * causal_depthwise_conv(u, conv_w[l])

        mixed = jnp.concatenate([o_gla, o_conv], axis=-1) @ w_out[l]
        x = x + mixed

        h2 = rmsnorm(x, norm2_g[l])
        ffn = (jax.nn.silu(h2 @ w_ffn_gate[l]) * (h2 @ w_ffn_up[l])) @ w_ffn_down[l]
        x = x + ffn
    return rmsnorm(x, norm_f_g)
```

```cpp
#include <hip/hip_runtime.h>
#include <cstdio>
#include <cstdint>
namespace pg8 {
#define PG8_LAS __attribute__((address_space(3)))
typedef unsigned short bf16_t;
typedef short bf16x8 __attribute__((ext_vector_type(8)));
typedef float f32x4 __attribute__((ext_vector_type(4)));
typedef unsigned u32x4 __attribute__((ext_vector_type(4)));
constexpr int BM = 256, BK = 64, HALF = 128, HTB = HALF * BK * 2  , STAGE_BYTES = 8 * HTB, NXCD = 8, WGM = 8;

__host__ __device__ __forceinline__ int lds_byte(int r, int c) { const int st = (r >> 4) * 2 + (c >> 5), rr = r & 15, cc = c & 31, ob = rr * 64 + cc * 2; return st * 1024 + (ob ^ (((ob >> 9) & 1) << 5)); }
__host__ __device__ __forceinline__ void stage_rc(int b, int& R, int& C) { const int st = b / 1024, sb = b % 1024, swz = sb ^ (((sb >> 9) & 1) << 5); R = (st >> 1) * 16 + swz / 64; C = (st & 1) * 32 + (swz % 64) / 2; }
__host__ __device__ __forceinline__ int perm32(int rho) { const int n = rho >> 4, i = rho & 15; return 8 * (i >> 2) + 4 * n + (i & 3); }

struct Unit { int pm, pn; };
struct Gemm { const bf16_t* A; const bf16_t* Bt; int M, N, K; };

struct StaticOrder {
    int nM, nN, nwg, G, c;
    __host__ __device__ void init(int M, int N, int G_, int c_) { nM = M / BM; nN = N / BM; nwg = nM * nN; G = G_; c = c_; }
    __host__ __device__ bool next(int i, Unit& u) const {
        const long L = (long)i * G + c; if (L >= nwg) return false;
        int wgid = (int)L; { const int q = nwg / NXCD, r = nwg % NXCD, xcd = wgid % NXCD, off = wgid / NXCD; wgid = (xcd < r ? xcd * (q + 1) : r * (q + 1) + (xcd - r) * q) + off; }
        const int nig = WGM * nN, gid = wgid / nig, fm = gid * WGM, gsz = (nM - fm) < WGM ? (nM - fm) : WGM;
        u.pm = fm + ((wgid % nig) % gsz); u.pn = (wgid % nig) / gsz; return true;
    }
    __device__ __forceinline__ void a_ready(const Unit&) const {}
    __device__ __forceinline__ void done(const Unit&) const {}
};

__device__ __forceinline__ unsigned cvt_pk_bf16(float lo, float hi) { unsigned r; asm volatile("v_cvt_pk_bf16_f32 %0, %1, %2" : "=v"(r) : "v"(lo), "v"(hi)); return r; }

__device__ __forceinline__ float fast_silu(float g) { return g * __builtin_amdgcn_rcpf(1.0f + __builtin_amdgcn_exp2f(-1.44269504089f * g)); }

struct EpiStoreBf16 {
    static constexpr bool PERM = true, AFTER_DRAIN = false;
    bf16_t* O; int ldc;
    __device__ __forceinline__ void operator()(const f32x4 (&acc)[2][2][4][2], const Unit& u, int wr, int wc, int fr, int fq) const {
        const int row0 = u.pm * BM + wr * 64 + fr, col0 = u.pn * BM + wc * 32 + 8 * fq;
#pragma unroll
        for (int ai = 0; ai < 2; ++ai)
#pragma unroll
            for (int m = 0; m < 4; ++m) { bf16_t* rowp = O + (size_t)(row0 + ai * HALF + m * 16) * ldc + col0;
#pragma unroll
                for (int bj = 0; bj < 2; ++bj) { const f32x4 v0 = acc[ai][bj][m][0], v1 = acc[ai][bj][m][1];
                    u32x4 w; w.x = cvt_pk_bf16(v0[0], v0[1]); w.y = cvt_pk_bf16(v0[2], v0[3]); w.z = cvt_pk_bf16(v1[0], v1[1]); w.w = cvt_pk_bf16(v1[2], v1[3]);
                    *(u32x4*)(rowp + bj * HALF) = w; } }
    }
};
template <bool WITH_BF16> struct EpiResid {
    static constexpr bool PERM = true, AFTER_DRAIN = false;
    const float* base; float* out; bf16_t* xb; float* ssq; int ldc;
    __device__ __forceinline__ void operator()(const f32x4 (&acc)[2][2][4][2], const Unit& u, int wr, int wc, int fr, int fq) const {
        const int row0 = u.pm * BM + wr * 64 + fr, col0 = u.pn * BM + wc * 32 + 8 * fq;
#pragma unroll
        for (int ai = 0; ai < 2; ++ai)
#pragma unroll
            for (int m = 0; m < 4; ++m) { const int row = row0 + ai * HALF + m * 16; const size_t off = (size_t)row * ldc + col0; float s = 0.f;
#pragma unroll
                for (int bj = 0; bj < 2; ++bj) {
                    const f32x4 b0 = *(const f32x4*)(base + off + bj * HALF), b1 = *(const f32x4*)(base + off + bj * HALF + 4);
                    const f32x4 v0 = acc[ai][bj][m][0] + b0, v1 = acc[ai][bj][m][1] + b1;
                    *(f32x4*)(out + off + bj * HALF) = v0; *(f32x4*)(out + off + bj * HALF + 4) = v1;
                    s += (v0[0] * v0[0] + v0[1] * v0[1]) + (v0[2] * v0[2] + v0[3] * v0[3]) + (v1[0] * v1[0] + v1[1] * v1[1]) + (v1[2] * v1[2] + v1[3] * v1[3]);
                    if (WITH_BF16) { u32x4 w; w.x = cvt_pk_bf16(v0[0], v0[1]); w.y = cvt_pk_bf16(v0[2], v0[3]); w.z = cvt_pk_bf16(v1[0], v1[1]); w.w = cvt_pk_bf16(v1[2], v1[3]);
                        *(u32x4*)(xb + off + bj * HALF) = w; } }
                s += __shfl_xor(s, 16); s += __shfl_xor(s, 32);
                if (fq == 0) ssq[(size_t)row * 16 + u.pn * 4 + wc] = s; }
    }
};
struct EpiSwiglu {
    static constexpr bool PERM = true, AFTER_DRAIN = false;
    bf16_t* H; int ldh; const float* ssq; float inv_n, eps;
    __device__ __forceinline__ void operator()(const f32x4 (&acc)[2][2][4][2], const Unit& u, int wr, int wc, int fr, int fq) const {
        const int row0 = u.pm * BM + wr * 64 + fr, col0 = u.pn * HALF + wc * 32 + 8 * fq;
#pragma unroll
        for (int ai = 0; ai < 2; ++ai)
#pragma unroll
            for (int m = 0; m < 4; ++m) { const int row = row0 + ai * HALF + m * 16;
                const f32x4* p = (const f32x4*)(ssq + (size_t)row * 16); const f32x4 a = p[0], b = p[1], c = p[2], d = p[3];
                const f32x4 t = (a + b) + (c + d); const float rstd = rsqrtf(((t[0] + t[1]) + (t[2] + t[3])) * inv_n + eps);
                float hv[8];
#pragma unroll
                for (int n = 0; n < 2; ++n)
#pragma unroll
                    for (int e = 0; e < 4; ++e) { const float g = acc[ai][0][m][n][e] * rstd, uu = acc[ai][1][m][n][e] * rstd; hv[n * 4 + e] = fast_silu(g) * uu; }
                u32x4 w; w.x = cvt_pk_bf16(hv[0], hv[1]); w.y = cvt_pk_bf16(hv[2], hv[3]); w.z = cvt_pk_bf16(hv[4], hv[5]); w.w = cvt_pk_bf16(hv[6], hv[7]);
                *(u32x4*)(H + (size_t)row * ldh + col0) = w; }
    }
};

template <class Epi, class Sched, bool ALIGN_EPI = false, bool SP2 = false>
__device__ __forceinline__ void gemm_phase(PG8_LAS unsigned char* lds, const Gemm g, const Sched& S, const Epi& E) {
    const int tid = threadIdx.x, wid = __builtin_amdgcn_readfirstlane(tid >> 6), lane = tid & 63, wr = wid >> 2, wc = wid & 3, fr = lane & 15, fq = lane >> 4;
    const int K = g.K, nt = K / BK;
    unsigned voffA[2], voffB[2];
#pragma unroll
    for (int i = 0; i < 2; ++i) { int R, C; stage_rc(tid * 16 + i * 8192, R, C); const int Rb = Epi::PERM ? ((R & ~31) + perm32(R & 31)) : R;
        voffA[i] = (unsigned)(R * K + C) * 2u; voffB[i] = (unsigned)(Rb * K + C) * 2u; }
    const size_t kstep = (size_t)(BK * 2);
    const size_t hstep = (size_t)HALF * K * 2;
    const size_t tstep = 2 * hstep;
    const unsigned ldsw = (unsigned)wid * 1024u;
    const int aoff = lds_byte(wr * 64 + fr, fq * 8), boff = lds_byte(wc * 32 + fr, fq * 8);
#define PG8_SA(b, h) (((b) * 2 + (h)) * HTB)
#define PG8_SB(b, h) ((4 + (b) * 2 + (h)) * HTB)
#define PG8_STAGE(bufoff, gbase, voff) do { _Pragma("unroll") for (int _i = 0; _i < 2; ++_i) \
        __builtin_amdgcn_global_load_lds((const unsigned*)((const char*)(gbase) + (voff)[_i]), (PG8_LAS unsigned*)(lds + (bufoff) + ldsw + _i * 8192), 16, 0, 0); } while (0)
#define PG8_LDA(dst, b, h) do { _Pragma("unroll") for (int m = 0; m < 4; ++m) _Pragma("unroll") for (int k = 0; k < 2; ++k) dst[m][k] = *(const PG8_LAS bf16x8*)(lds + PG8_SA(b, h) + aoff + m * 2048 + k * 1024); } while (0)
#define PG8_LDB(dst, b, h) do { _Pragma("unroll") for (int n = 0; n < 2; ++n) _Pragma("unroll") for (int k = 0; k < 2; ++k) dst[n][k] = *(const PG8_LAS bf16x8*)(lds + PG8_SB(b, h) + boff + n * 2048 + k * 1024); } while (0)
#define PG8_MMA(ai, bj, At, Bt) do { __builtin_amdgcn_s_setprio(1); _Pragma("unroll") for (int m = 0; m < 4; ++m) _Pragma("unroll") for (int n = 0; n < 2; ++n) _Pragma("unroll") for (int k = 0; k < 2; ++k) \
        acc[ai][bj][m][n] = __builtin_amdgcn_mfma_f32_16x16x32_bf16(Bt[n][k], At[m][k], acc[ai][bj][m][n], 0, 0, 0); __builtin_amdgcn_s_setprio(0); } while (0)
#define PG8_WAIT_V(n) asm volatile("s_waitcnt vmcnt(" #n ")" ::: "memory")
#define PG8_WAIT_L(n) asm volatile("s_waitcnt lgkmcnt(" #n ")" ::: "memory")
#define PG8_BAR __builtin_amdgcn_s_barrier()
#define PG8_SCHED __builtin_amdgcn_sched_barrier(0)
    Unit cur, nxt; int ui = 0;
    if (!S.next(0, cur)) return;
    f32x4 acc[2][2][4][2];
#pragma unroll
    for (int a = 0; a < 2; ++a)
#pragma unroll
        for (int b = 0; b < 2; ++b)
#pragma unroll
            for (int m = 0; m < 4; ++m)
#pragma unroll
                for (int n = 0; n < 2; ++n) acc[a][b][m][n] = (f32x4){0.f, 0.f, 0.f, 0.f};
    bf16x8 At[4][2], B0[2][2], B1[2][2];
    const char* cA = (const char*)g.A + (size_t)cur.pm * tstep; const char* cB = (const char*)g.Bt + (size_t)cur.pn * tstep;
    S.a_ready(cur);
    if constexpr (SP2) {
        PG8_STAGE(PG8_SB(0, 0), cB, voffB); PG8_STAGE(PG8_SB(0, 1), cB + hstep, voffB); PG8_STAGE(PG8_SA(0, 0), cA, voffA); PG8_STAGE(PG8_SA(0, 1), cA + hstep, voffA);
        if (wr == 1) PG8_BAR;
        PG8_WAIT_V(2); PG8_BAR;
        PG8_STAGE(PG8_SB(1, 0), cB + kstep, voffB); PG8_STAGE(PG8_SA(1, 0), cA + kstep, voffA); PG8_STAGE(PG8_SB(1, 1), cB + hstep + kstep, voffB);
        PG8_WAIT_V(6); PG8_BAR;
    } else {
        PG8_STAGE(PG8_SB(0, 0), cB, voffB); PG8_STAGE(PG8_SA(0, 0), cA, voffA); PG8_STAGE(PG8_SB(0, 1), cB + hstep, voffB); PG8_STAGE(PG8_SA(0, 1), cA + hstep, voffA);
        if (wr == 1) PG8_BAR;
        PG8_WAIT_V(4); PG8_BAR;
        PG8_STAGE(PG8_SB(1, 0), cB + kstep, voffB); PG8_STAGE(PG8_SA(1, 0), cA + kstep, voffA); PG8_STAGE(PG8_SB(1, 1), cB + hstep + kstep, voffB);
        PG8_WAIT_V(6); PG8_BAR;
    }
    for (;;) {
        const bool has_next = S.next(ui + 1, nxt);
        const char* nA = has_next ? (const char*)g.A + (size_t)nxt.pm * tstep : cA; const char* nB = has_next ? (const char*)g.Bt + (size_t)nxt.pn * tstep : cB;
        for (int t = 0; t < nt; t += 2) {
            const bool last = (t == nt - 2);
            const char* a1 = cA + (size_t)(t + 1) * kstep;
            const char* a2 = last ? nA : cA + (size_t)(t + 2) * kstep; const char* b2 = last ? nB : cB + (size_t)(t + 2) * kstep;
            const char* a3 = a2 + kstep; const char* b3 = b2 + kstep;
            if (last && has_next) S.a_ready(nxt);
            if constexpr (SP2) {
            PG8_LDB(B0, 0, 0); PG8_LDB(B1, 0, 1); PG8_SCHED; PG8_LDA(At, 0, 0); PG8_STAGE(PG8_SA(1, 1), a1 + hstep, voffA);
            PG8_WAIT_V(8); PG8_WAIT_L(0); PG8_BAR; PG8_MMA(0, 0, At, B0); PG8_MMA(0, 1, At, B1); PG8_BAR; PG8_SCHED;
            PG8_LDA(At, 0, 1); PG8_STAGE(PG8_SB(0, 0), b2, voffB); PG8_STAGE(PG8_SB(0, 1), b2 + hstep, voffB); PG8_STAGE(PG8_SA(0, 0), a2, voffA);
            PG8_WAIT_V(8); PG8_WAIT_L(0); PG8_BAR; PG8_MMA(1, 0, At, B0); PG8_MMA(1, 1, At, B1); PG8_BAR; PG8_SCHED;
            PG8_LDB(B0, 1, 0); PG8_LDB(B1, 1, 1); PG8_SCHED; PG8_LDA(At, 1, 0); PG8_STAGE(PG8_SA(0, 1), a2 + hstep, voffA);
            PG8_WAIT_V(8); PG8_WAIT_L(0); PG8_BAR; PG8_MMA(0, 0, At, B0); PG8_MMA(0, 1, At, B1); PG8_BAR; PG8_SCHED;
            PG8_LDA(At, 1, 1); PG8_STAGE(PG8_SB(1, 0), b3, voffB); PG8_STAGE(PG8_SB(1, 1), b3 + hstep, voffB); PG8_STAGE(PG8_SA(1, 0), a3, voffA);
            PG8_WAIT_V(8); PG8_WAIT_L(0); PG8_BAR; PG8_MMA(1, 0, At, B0); PG8_MMA(1, 1, At, B1); PG8_BAR; PG8_SCHED;
            } else {
            PG8_LDB(B0, 0, 0); PG8_SCHED; PG8_LDA(At, 0, 0); PG8_STAGE(PG8_SA(1, 1), a1 + hstep, voffA);
            PG8_WAIT_L(8); PG8_BAR; PG8_WAIT_L(0); PG8_MMA(0, 0, At, B0); PG8_BAR; PG8_SCHED;
            PG8_LDB(B1, 0, 1); PG8_STAGE(PG8_SB(0, 0), b2, voffB);
            PG8_BAR; PG8_WAIT_L(0); PG8_MMA(0, 1, At, B1); PG8_BAR;
            PG8_LDA(At, 0, 1); PG8_STAGE(PG8_SA(0, 0), a2, voffA);
            PG8_BAR; PG8_WAIT_L(0); PG8_MMA(1, 0, At, B0); PG8_BAR; PG8_SCHED;
            PG8_STAGE(PG8_SB(0, 1), b2 + hstep, voffB);
            PG8_WAIT_V(6); PG8_BAR; PG8_MMA(1, 1, At, B1); PG8_BAR;
            PG8_LDB(B0, 1, 0); PG8_SCHED; PG8_LDA(At, 1, 0); PG8_STAGE(PG8_SA(0, 1), a2 + hstep, voffA);
            PG8_WAIT_L(8); PG8_BAR; PG8_WAIT_L(0); PG8_MMA(0, 0, At, B0); PG8_BAR; PG8_SCHED;
            PG8_LDB(B1, 1, 1); PG8_STAGE(PG8_SB(1, 0), b3, voffB);
            PG8_BAR; PG8_WAIT_L(0); PG8_MMA(0, 1, At, B1); PG8_BAR;
            PG8_LDA(At, 1, 1); PG8_STAGE(PG8_SA(1, 0), a3, voffA);
            PG8_BAR; PG8_WAIT_L(0); PG8_MMA(1, 0, At, B0); PG8_BAR; PG8_SCHED;
            PG8_STAGE(PG8_SB(1, 1), b3 + hstep, voffB);
            PG8_WAIT_V(6); PG8_BAR; PG8_MMA(1, 1, At, B1); PG8_BAR;
            }
        }
        if constexpr (ALIGN_EPI) { if (wr == 0) PG8_BAR; }
        if constexpr (!Epi::AFTER_DRAIN) { E(acc, cur, wr, wc, fr, fq); S.done(cur); }
        if (!has_next) break;
#pragma unroll
        for (int a = 0; a < 2; ++a)
#pragma unroll
            for (int b = 0; b < 2; ++b)
#pragma unroll
                for (int m = 0; m < 4; ++m)
#pragma unroll
                    for (int n = 0; n < 2; ++n) acc[a][b][m][n] = (f32x4){0.f, 0.f, 0.f, 0.f};
        cur = nxt; cA = nA; cB = nB; ++ui;
        if constexpr (ALIGN_EPI) { if (wr == 1) PG8_BAR; }
    }
    PG8_WAIT_V(0);
    if constexpr (!ALIGN_EPI) { if (wr == 0) PG8_BAR; }
    PG8_BAR;
    if constexpr (Epi::AFTER_DRAIN) { E.fused(acc, cur, wr, wc, fr, fq, lds, wid, lane); S.done(cur); }
#undef PG8_SA
#undef PG8_SB
#undef PG8_STAGE
#undef PG8_LDA
#undef PG8_LDB
#undef PG8_MMA
#undef PG8_WAIT_V
#undef PG8_WAIT_L
#undef PG8_BAR
#undef PG8_SCHED
}
}

#ifndef PG8_SP2
#define PG8_SP2 true
#endif
#ifndef PG8_ALIGN
#define PG8_ALIGN true
#endif

#define GAS __attribute__((address_space(1)))
#define LAS __attribute__((address_space(3)))
typedef unsigned short bf16;
typedef unsigned v4u __attribute__((ext_vector_type(4)));
typedef float f32x4 __attribute__((ext_vector_type(4)));
typedef short bf16x8 __attribute__((ext_vector_type(8)));
typedef GAS unsigned gu32;
typedef GAS unsigned long long gu64;
#define RLX_AGENT __ATOMIC_RELAXED, __HIP_MEMORY_SCOPE_AGENT
#define LDS_WAIT() asm volatile("s_waitcnt lgkmcnt(0)" ::: "memory")
#define VM_WAIT() asm volatile("s_waitcnt vmcnt(0)" ::: "memory")
__device__ __forceinline__ unsigned long long rt() { return __builtin_amdgcn_s_memrealtime(); }
__device__ __forceinline__ unsigned f2bf(float f) { unsigned u = __builtin_bit_cast(unsigned, f); return (u + 0x7fffu + ((u >> 16) & 1u)) >> 16; }
__device__ __forceinline__ unsigned pk2(float lo, float hi) { return f2bf(lo) | (f2bf(hi) << 16); }

#define XB_TMO      128
#define XB_XCNT(j)  (256  + 64 * (j))
#define XB_XSUB(j)  (1280 + 64 * (j))
#define XB_XGEN(j)  (2304 + 64 * (j))
#define XB_TOP      3328
#define XB_TOPGEN   3392
#define XCD_BAR_WORDS 3456
#define XB_SPIN_CAP (1u << 18)

__device__ __forceinline__ unsigned xb_ld(unsigned* p)              { return __hip_atomic_load(p, __ATOMIC_RELAXED, __HIP_MEMORY_SCOPE_AGENT); }
__device__ __forceinline__ unsigned xb_add(unsigned* p, unsigned v) { return __hip_atomic_fetch_add(p, v, __ATOMIC_RELAXED, __HIP_MEMORY_SCOPE_AGENT); }
__device__ __forceinline__ unsigned xb_xcc_id() { return (unsigned)__builtin_amdgcn_s_getreg((3 << 11) | 20) & 0xFu; }
#define XB_SPIN(cond, bar) do { unsigned _sp = 0; while (cond) { __builtin_amdgcn_s_sleep(1); \
    if ((++_sp & 255u) == 0u) { if (xb_ld(&(bar)[XB_TMO])) break; if (_sp > XB_SPIN_CAP) { atomicAdd(&(bar)[XB_TMO], 1u); break; } } } } while (0)

struct XcdBarrier {
    unsigned* bar; unsigned x;
    volatile LAS unsigned* st;
};

__device__ __forceinline__ XcdBarrier xcd_barrier_post(unsigned* bar, volatile LAS unsigned* st) {
    XcdBarrier b; b.bar = bar; b.x = xb_xcc_id(); b.st = st;
    if (threadIdx.x == 0) (void)xb_add(&bar[XB_XCNT(b.x)], 1u);
    return b;
}
__device__ __forceinline__ void xcd_barrier_complete(unsigned* bar, unsigned x, unsigned& nloc, unsigned& nx) {
    const unsigned G = gridDim.x * gridDim.y * gridDim.z;
    unsigned sum, cnt, mine, sp = 0u;
    for (;;) {
        sum = 0u; cnt = 0u; mine = 0u;
#pragma unroll
        for (unsigned j = 0; j < 16; ++j) { const unsigned c = xb_ld(&bar[XB_XCNT(j)]); sum += c; cnt += (c > 0u) ? 1u : 0u; mine = (j == x) ? c : mine; }
        if (sum == G) break;
        __builtin_amdgcn_s_sleep(1);
        if ((++sp & 255u) == 0u) { if (xb_ld(&bar[XB_TMO])) break; if (sp > XB_SPIN_CAP) { atomicAdd(&bar[XB_TMO], 1u); break; } }
    }
    nloc = mine > 0u ? mine : 1u; nx = cnt > 0u ? cnt : 1u;
}

__device__ __forceinline__ void xcd_barrier(const XcdBarrier& b) {
    asm volatile("s_waitcnt vmcnt(0)" ::: "memory");
    __syncthreads();
    if (threadIdx.x == 0) {
        unsigned* bar = b.bar;
        __builtin_amdgcn_s_waitcnt(0);
        unsigned nloc = b.st[0], nx = b.st[1];
        if (nloc == 0u) { xcd_barrier_complete(bar, b.x, nloc, nx); b.st[0] = nloc; b.st[1] = nx; }
        const unsigned old = xb_add(&bar[XB_XSUB(b.x)], 1u);
        const unsigned gen = old / nloc;
        if (old + 1u == (gen + 1u) * nloc) {
            __builtin_amdgcn_fence(__ATOMIC_RELEASE, "agent");
            asm volatile("s_waitcnt vmcnt(0)" ::: "memory");
            const unsigned og = xb_add(&bar[XB_TOP], 1u);
            const unsigned tg = og / nx;
            if (og + 1u == (tg + 1u) * nx) xb_add(&bar[XB_TOPGEN], 1u);
            else XB_SPIN(xb_ld(&bar[XB_TOPGEN]) == tg, bar);
            __builtin_amdgcn_fence(__ATOMIC_ACQUIRE, "agent");
            xb_add(&bar[XB_XGEN(b.x)], 1u);
            asm volatile("s_waitcnt vmcnt(0)" ::: "memory");
        } else {
            XB_SPIN(xb_ld(&bar[XB_XGEN(b.x)]) == gen, bar);
            __builtin_amdgcn_fence(__ATOMIC_ACQUIRE, "agent");
            asm volatile("s_waitcnt vmcnt(0)" ::: "memory");
        }
    }
    __syncthreads();
}

constexpr int NWAVES = 8;
#ifndef MK_N_LAUNCHES
#define MK_N_LAUNCHES 1
#endif
constexpr int N_LAUNCHES = MK_N_LAUNCHES;
constexpr int N_PHASES = 7;
constexpr int BATCH = 16, SEQ = 2048, D = 1024, M = BATCH * SEQ;
constexpr int GH = 4, GDK = 64, GDV = 128, CHUNK = 64, RANK = 16, CONVW = 512, FF = 2816;
constexpr int IN_COLS = 3088;
constexpr int SRC_A = 1536, SRC_CB = 1552;
constexpr int NP = 3328;
constexpr int PC_Q = 0, PC_K = 256, PC_V = 512, PC_G = 1024, PC_GATE = 1536, PC_CB = 1792, PC_CC = 2304, PC_CH = 2816;
constexpr int NGU = 2 * FF;
constexpr float EPS = 1e-6f;

constexpr size_t MiB = 1u << 20;
constexpr size_t WS_CTL = 0, CTL_ZERO_BYTES = 1 * MiB;
constexpr size_t WS_WIN = 2 * MiB, WS_WOUT = 10 * MiB, WS_WGU = 12 * MiB, WS_WDN = 24 * MiB;
constexpr size_t WS_SSQ1 = 30 * MiB, WS_SSQ2 = 32 * MiB;
constexpr size_t WS_XN = 64 * MiB;
constexpr size_t WS_PROJ = 128 * MiB;
constexpr size_t WS_MIX = 336 * MiB;
constexpr size_t WS_END = 400 * MiB;
static_assert(WS_WIN + (size_t)NP * D * 2 <= WS_WOUT && WS_WOUT + (size_t)D * D * 2 <= WS_WGU && WS_WGU + (size_t)NGU * D * 2 <= WS_WDN && WS_WDN + (size_t)D * FF * 2 <= WS_SSQ1, "weights");
static_assert(WS_SSQ1 + (size_t)M * 16 * 4 <= WS_SSQ2 && WS_SSQ2 + (size_t)M * 16 * 4 <= WS_XN && WS_XN + (size_t)M * D * 2 <= WS_PROJ && WS_PROJ + (size_t)M * NP * 2 <= WS_MIX && WS_PROJ + (size_t)M * FF * 2 <= WS_MIX && WS_MIX + (size_t)M * D * 2 <= WS_END, "d_ws map");
constexpr int CW_BAR = 4096;

constexpr int RING_OFF = 0, RING_BYTES = 131072;
constexpr int LDSCTL_OFF = RING_BYTES, MISC_OFF = LDSCTL_OFF + 320;
constexpr int LDS_BYTES = 147456;
static_assert(MISC_OFF + 128 <= LDS_BYTES, "LDS map");

__device__ __forceinline__ float wave_sum(float v) {
#pragma unroll
    for (int o = 1; o < 64; o <<= 1) v += __shfl_xor(v, o);
    return v;
}
__device__ __forceinline__ float bf_lo(unsigned w) { return __builtin_bit_cast(float, w << 16); }
__device__ __forceinline__ float bf_hi(unsigned w) { return __builtin_bit_cast(float, w & 0xffff0000u); }

__device__ __forceinline__ void p0_transpose_item(const float* W, int ld, int K, bf16* WT, int row_off, int kb, int nb, const float* kscale, float scale, LAS float* scr, int lane) {
    const int k0 = 64 * kb, n0 = 32 * nb;
#pragma unroll 8
    for (int i = 0; i < 32; ++i) { const int kk = 2 * i + (lane >> 5); float v = W[(size_t)(k0 + kk) * ld + n0 + (lane & 31)] * scale; if (kscale) v *= kscale[k0 + kk]; scr[kk * 33 + (lane & 31)] = v; }
    LDS_WAIT(); asm volatile("" ::: "memory");
    const int c = lane & 7;
#pragma unroll
    for (int j = 0; j < 4; ++j) { const int n = (lane >> 3) + 8 * j; const LAS float* s = scr + (8 * c) * 33 + n;
        v4u o; o.x = pk2(s[0 * 33], s[1 * 33]); o.y = pk2(s[2 * 33], s[3 * 33]); o.z = pk2(s[4 * 33], s[5 * 33]); o.w = pk2(s[6 * 33], s[7 * 33]);
        *(GAS v4u*)(WT + (size_t)(row_off + n0 + n) * K + k0 + 8 * c) = o; }
    LDS_WAIT(); asm volatile("" ::: "memory");
}
__device__ __forceinline__ void p0_gate_item(const float* w_in, const float* wgu, bf16* WT, int kb, int jb, int lane) {
    const int k = 64 * kb + lane; float a[RANK];
#pragma unroll
    for (int r = 0; r < RANK; ++r) a[r] = w_in[(size_t)k * IN_COLS + SRC_A + r];
#pragma unroll
    for (int jj = 0; jj < 8; ++jj) { const int j = 8 * jb + jj; float s = 0.f;
#pragma unroll
        for (int r = 0; r < RANK; ++r) s += a[r] * wgu[r * 256 + j];
        WT[(size_t)(PC_GATE + j) * D + k] = (bf16)f2bf(s); }
}
__device__ __forceinline__ void rms_row_to_bf16(const float* xrow, const float* g, bf16* orow, int lane) {
    const GAS f32x4* xr = (const GAS f32x4*)xrow + lane; const GAS f32x4* gr = (const GAS f32x4*)g + lane;
    f32x4 v[4]; float s = 0.f;
#pragma unroll
    for (int j = 0; j < 4; ++j) { v[j] = xr[64 * j]; s += (v[j].x * v[j].x + v[j].y * v[j].y) + (v[j].z * v[j].z + v[j].w * v[j].w); }
    const float rstd = rsqrtf(wave_sum(s) * (1.f / D) + EPS);
    GAS unsigned long long* o8 = (GAS unsigned long long*)orow + lane;
#pragma unroll
    for (int j = 0; j < 4; ++j) { const f32x4 gg = gr[64 * j]; o8[64 * j] = (unsigned long long)pk2(v[j].x * rstd * gg.x, v[j].y * rstd * gg.y) | ((unsigned long long)pk2(v[j].z * rstd * gg.z, v[j].w * rstd * gg.w) << 32); }
}

struct Args { const float* in[13]; float* out; unsigned char* ws; int ph_lo, ph_hi; };
static_assert(sizeof(Args) == 13 * 8 + 8 + 8 + 8, "Args has no padding");

__global__ void __launch_bounds__(NWAVES * 64, 2) hymba_fwd(Args args) {
    extern __shared__ __attribute__((aligned(16))) unsigned char lds_raw[];
    LAS unsigned char* lds = (LAS unsigned char*)lds_raw;
    volatile LAS unsigned* MISC = (volatile LAS unsigned*)(lds + MISC_OFF);
    const int tid = threadIdx.x, lane = tid & 63, wave = __builtin_amdgcn_readfirstlane(tid >> 6);
    const int G = gridDim.x, bx = blockIdx.x;
    const int vcu = (G % 8 == 0) ? (bx % 8) * (G / 8) + bx / 8 : bx;
    unsigned char* ws = args.ws;
    gu32* ctl = (gu32*)(ws + WS_CTL);
    const float* x = args.in[0]; const float* norm1_g = args.in[1]; const float* w_in = args.in[2]; const float* w_gate_up = args.in[3]; const float* b_gate = args.in[4];
    const float* gla_g = args.in[5]; const float* conv_w = args.in[6]; const float* w_out = args.in[7]; const float* norm2_g = args.in[8];
    const float* w_fg = args.in[9]; const float* w_fu = args.in[10]; const float* w_fd = args.in[11]; const float* normf_g = args.in[12];
    float* out = args.out;
    bf16* WIN = (bf16*)(ws + WS_WIN); bf16* WOUT = (bf16*)(ws + WS_WOUT); bf16* WGU = (bf16*)(ws + WS_WGU); bf16* WDN = (bf16*)(ws + WS_WDN);
    float* SSQ1 = (float*)(ws + WS_SSQ1); float* SSQ2 = (float*)(ws + WS_SSQ2);
    bf16* XN = (bf16*)(ws + WS_XN); bf16* PROJ = (bf16*)(ws + WS_PROJ); bf16* HID = (bf16*)(ws + WS_PROJ); bf16* MIX = (bf16*)(ws + WS_MIX);

    for (int u = tid; u < (LDS_BYTES - LDSCTL_OFF) / 4; u += NWAVES * 64) ((LAS unsigned*)(lds + LDSCTL_OFF))[u] = 0u;
    __syncthreads();
    XcdBarrier bar; bar.bar = (unsigned*)(ctl + CW_BAR); bar.x = 0; bar.st = nullptr;
    if (N_LAUNCHES == 1) bar = xcd_barrier_post((unsigned*)(ctl + CW_BAR), MISC + 8);
#define GRID_BAR() do { if (N_LAUNCHES == 1) xcd_barrier(bar); } while (0)
    const int lo = args.ph_lo, hi = args.ph_hi;
#define IN(k) (lo <= (k) && (k) < hi)
#define BOTH(k) (IN(k) && IN((k) + 1))
    const int gw = vcu * NWAVES + wave, NGW = G * NWAVES;

    if (IN(0)) {
        LAS float* scr = (LAS float*)(lds + RING_OFF + wave * 16384);
        constexpr int I_IN1 = 16 * 48, I_IN2 = 16 * 48, I_GATE = 16 * 32, I_OUT = 16 * 32, I_FG = 16 * 88, I_FU = 16 * 88, I_FD = 44 * 32;
        constexpr int NITEMS = I_IN1 + I_IN2 + I_GATE + I_OUT + I_FG + I_FU + I_FD;
        for (int it = gw; it < NITEMS; it += NGW) {
            int r = it;
            if (r < I_IN1) { const int kb = r / 48, nb = r % 48; p0_transpose_item(w_in, IN_COLS, D, WIN, 0, kb, nb, nullptr, nb < 8 ? 0.125f : 1.0f, scr, lane); continue; } r -= I_IN1;
            if (r < I_IN2) { const int kb = r / 48, nb = r % 48; p0_transpose_item(w_in + SRC_CB, IN_COLS, D, WIN, PC_CB, kb, nb, nullptr, 1.0f, scr, lane); continue; } r -= I_IN2;
            if (r < I_GATE) { p0_gate_item(w_in, w_gate_up, WIN, r / 32, r % 32, lane); continue; } r -= I_GATE;
            if (r < I_OUT) { p0_transpose_item(w_out, D, D, WOUT, 0, r / 32, r % 32, nullptr, 1.0f, scr, lane); continue; } r -= I_OUT;
            if (r < I_FG) { const int kb = r / 88, nb = r % 88, n0 = 32 * nb; p0_transpose_item(w_fg, FF, D, WGU, 256 * (n0 / 128) + (n0 % 128) - n0, kb, nb, norm2_g, 1.0f, scr, lane); continue; } r -= I_FG;
            if (r < I_FU) { const int kb = r / 88, nb = r % 88, n0 = 32 * nb; p0_transpose_item(w_fu, FF, D, WGU, 256 * (n0 / 128) + 128 + (n0 % 128) - n0, kb, nb, norm2_g, 1.0f, scr, lane); continue; } r -= I_FU;
            p0_transpose_item(w_fd, D, FF, WDN, 0, r / 32, r % 32, nullptr, 1.0f, scr, lane);
        }
        for (int m = gw; m < M; m += NGW) rms_row_to_bf16(x + (size_t)m * D, norm1_g, XN + (size_t)m * D, lane);
        if (BOTH(0)) GRID_BAR();
    }

    if (IN(1)) {
        pg8::Gemm g{XN, WIN, M, NP, D}; pg8::StaticOrder S; S.init(M, NP, G, bx);
        pg8::EpiStoreBf16 E{PROJ, NP};
        pg8::gemm_phase<pg8::EpiStoreBf16, pg8::StaticOrder, PG8_ALIGN, PG8_SP2>(lds + RING_OFF, g, S, E);
        if (BOTH(1)) GRID_BAR();
    }

    if (IN(2)) {
        const bool do_gla = (G <= 64) || (bx < 64), do_conv = (G <= 64) || (bx >= 64);
        if (do_gla) {
            LAS float* Lq = (LAS float*)(lds);
            LAS float* Lk = Lq + 64 * 64;
            LAS float* La = Lk + 64 * 64;
            LAS float* Lv = La + 64 * 64;
            LAS float* Lo = Lv + 64 * 128;
            for (int unit = bx; unit < BATCH * GH; unit += G) {
                const int b = unit >> 2, h = unit & 3;
                float S[16];
#pragma unroll
                for (int i = 0; i < 16; ++i) S[i] = 0.f;
                const int dvl = 16 * wave + (lane & 15), dkq = lane >> 4;
                for (int n = 0; n < SEQ / CHUNK; ++n) {
                    const size_t row0 = (size_t)b * SEQ + (size_t)n * CHUNK;
                    {
                        const int r = tid >> 3, c8 = (tid & 7) * 8; const bf16* pr = PROJ + (row0 + r) * NP;
                        const v4u wq = *(const GAS v4u*)(pr + PC_Q + h * 64 + c8), wk = *(const GAS v4u*)(pr + PC_K + h * 64 + c8), wg = *(const GAS v4u*)(pr + PC_GATE + h * 64 + c8);
                        const v4u wv0 = *(const GAS v4u*)(pr + PC_V + h * 128 + c8), wv1 = *(const GAS v4u*)(pr + PC_V + h * 128 + 64 + c8);
                        const unsigned qa[4] = {wq.x, wq.y, wq.z, wq.w}, ka[4] = {wk.x, wk.y, wk.z, wk.w}, ga[4] = {wg.x, wg.y, wg.z, wg.w}, va[4] = {wv0.x, wv0.y, wv0.z, wv0.w}, vb[4] = {wv1.x, wv1.y, wv1.z, wv1.w};
#pragma unroll
                        for (int e = 0; e < 4; ++e) {
                            Lq[r * 64 + c8 + 2 * e] = bf_lo(qa[e]); Lq[r * 64 + c8 + 2 * e + 1] = bf_hi(qa[e]);
                            Lk[r * 64 + c8 + 2 * e] = bf_lo(ka[e]); Lk[r * 64 + c8 + 2 * e + 1] = bf_hi(ka[e]);
                            Lv[r * 128 + c8 + 2 * e] = bf_lo(va[e]); Lv[r * 128 + c8 + 2 * e + 1] = bf_hi(va[e]);
                            Lv[r * 128 + 64 + c8 + 2 * e] = bf_lo(vb[e]); Lv[r * 128 + 64 + c8 + 2 * e + 1] = bf_hi(vb[e]);
                            const float z0 = bf_lo(ga[e]) + b_gate[h * 64 + c8 + 2 * e], z1 = bf_hi(ga[e]) + b_gate[h * 64 + c8 + 2 * e + 1];
                            const float l0 = (fminf(z0, 0.f) - log1pf(__expf(-fabsf(z0)))) * (1.f / 16.f), l1 = (fminf(z1, 0.f) - log1pf(__expf(-fabsf(z1)))) * (1.f / 16.f);
                            La[r * 64 + c8 + 2 * e] = __expf(l0); La[r * 64 + c8 + 2 * e + 1] = __expf(l1);
                        }
                    }
                    __syncthreads();
                    for (int t = 0; t < CHUNK; ++t) {
                        const float vv = Lv[t * 128 + dvl]; float o = 0.f;
#pragma unroll
                        for (int i4 = 0; i4 < 4; ++i4) {
                            const f32x4 a4 = *(const LAS f32x4*)(La + t * 64 + 16 * dkq + 4 * i4), k4 = *(const LAS f32x4*)(Lk + t * 64 + 16 * dkq + 4 * i4), q4 = *(const LAS f32x4*)(Lq + t * 64 + 16 * dkq + 4 * i4);
#pragma unroll
                            for (int e = 0; e < 4; ++e) { S[4 * i4 + e] = a4[e] * S[4 * i4 + e] + k4[e] * vv; o += q4[e] * S[4 * i4 + e]; }
                        }
                        o += __shfl_xor(o, 16); o += __shfl_xor(o, 32);
                        if (dkq == 0) Lo[t * 128 + dvl] = o;
                    }
                    __syncthreads();
                    {
                        const int t = tid >> 3, p = tid & 7; float ov[16]; float s = 0.f;
#pragma unroll
                        for (int i4 = 0; i4 < 4; ++i4) { const f32x4 o4 = *(const LAS f32x4*)(Lo + t * 128 + 16 * p + 4 * i4);
#pragma unroll
                            for (int e = 0; e < 4; ++e) { ov[4 * i4 + e] = o4[e]; s += o4[e] * o4[e]; } }
                        s += __shfl_xor(s, 1); s += __shfl_xor(s, 2); s += __shfl_xor(s, 4);
                        const float rstd = rsqrtf(s * (1.f / GDV) + EPS);
                        const bf16* pg = PROJ + (row0 + t) * NP + PC_G + h * 128 + 16 * p;
                        const v4u g0 = *(const GAS v4u*)pg, g1 = *(const GAS v4u*)(pg + 8);
                        const unsigned gw_[8] = {g0.x, g0.y, g0.z, g0.w, g1.x, g1.y, g1.z, g1.w};
                        unsigned ow[8];
#pragma unroll
                        for (int e = 0; e < 8; ++e) {
                            const float n0 = ov[2 * e] * rstd * gla_g[16 * p + 2 * e], n1 = ov[2 * e + 1] * rstd * gla_g[16 * p + 2 * e + 1];
                            ow[e] = pk2(n0 * pg8::fast_silu(bf_lo(gw_[e])), n1 * pg8::fast_silu(bf_hi(gw_[e])));
                        }
                        bf16* po = MIX + (row0 + t) * D + h * 128 + 16 * p;
                        *(GAS v4u*)po = (v4u){ow[0], ow[1], ow[2], ow[3]}; *(GAS v4u*)(po + 8) = (v4u){ow[4], ow[5], ow[6], ow[7]};
                    }
                    __syncthreads();
                }
            }
        }
        if (do_conv) {
            const int ncw = ((G <= 64) ? G : G - 64) * NWAVES, cw = ((G <= 64) ? bx : bx - 64) * NWAVES + wave;
            const int c0 = lane * 8;
            float w0[8], w1[8], w2[8];
#pragma unroll
            for (int e = 0; e < 8; ++e) { w0[e] = conv_w[c0 + e]; w1[e] = conv_w[CONVW + c0 + e]; w2[e] = conv_w[2 * CONVW + c0 + e]; }
            for (int item = cw; item < M / 8; item += ncw) {
                const int m0 = item * 8, s0 = m0 % SEQ;
                float um2[8], um1[8];
#pragma unroll
                for (int e = 0; e < 8; ++e) { um2[e] = 0.f; um1[e] = 0.f; }
                if (s0 > 0) {
#pragma unroll
                    for (int back = 2; back >= 1; --back) { const bf16* pr = PROJ + (size_t)(m0 - back) * NP;
                        const v4u cc = *(const GAS v4u*)(pr + PC_CC + c0), ch = *(const GAS v4u*)(pr + PC_CH + c0);
                        const unsigned ca[4] = {cc.x, cc.y, cc.z, cc.w}, ha[4] = {ch.x, ch.y, ch.z, ch.w};
#pragma unroll
                        for (int e = 0; e < 4; ++e) { const float u0 = bf_lo(ca[e]) * bf_lo(ha[e]), u1 = bf_hi(ca[e]) * bf_hi(ha[e]);
                            if (back == 2) { um2[2 * e] = u0; um2[2 * e + 1] = u1; } else { um1[2 * e] = u0; um1[2 * e + 1] = u1; } } }
                }
#pragma unroll
                for (int rr = 0; rr < 8; ++rr) { const bf16* pr = PROJ + (size_t)(m0 + rr) * NP;
                    const v4u cb = *(const GAS v4u*)(pr + PC_CB + c0), cc = *(const GAS v4u*)(pr + PC_CC + c0), ch = *(const GAS v4u*)(pr + PC_CH + c0);
                    const unsigned ba[4] = {cb.x, cb.y, cb.z, cb.w}, ca[4] = {cc.x, cc.y, cc.z, cc.w}, ha[4] = {ch.x, ch.y, ch.z, ch.w};
                    unsigned ow[4];
#pragma unroll
                    for (int e = 0; e < 4; ++e) { const float u0 = bf_lo(ca[e]) * bf_lo(ha[e]), u1 = bf_hi(ca[e]) * bf_hi(ha[e]);
                        const float y0 = w0[2 * e] * um2[2 * e] + w1[2 * e] * um1[2 * e] + w2[2 * e] * u0, y1 = w0[2 * e + 1] * um2[2 * e + 1] + w1[2 * e + 1] * um1[2 * e + 1] + w2[2 * e + 1] * u1;
                        ow[e] = pk2(bf_lo(ba[e]) * y0, bf_hi(ba[e]) * y1);
                        um2[2 * e] = um1[2 * e]; um2[2 * e + 1] = um1[2 * e + 1]; um1[2 * e] = u0; um1[2 * e + 1] = u1; }
                    *(GAS v4u*)(MIX + (size_t)(m0 + rr) * D + CONVW + c0) = (v4u){ow[0], ow[1], ow[2], ow[3]}; }
            }
        }
        if (BOTH(2)) GRID_BAR();
    }

    if (IN(3)) {
        pg8::Gemm g{MIX, WOUT, M, D, D}; pg8::StaticOrder S; S.init(M, D, G, bx);
        pg8::EpiResid<true> E{x, out, XN, SSQ1, D};
        pg8::gemm_phase<pg8::EpiResid<true>, pg8::StaticOrder, PG8_ALIGN, PG8_SP2>(lds + RING_OFF, g, S, E);
        if (BOTH(3)) GRID_BAR();
    }

    if (IN(4)) {
        pg8::Gemm g{XN, WGU, M, NGU, D}; pg8::StaticOrder S; S.init(M, NGU, G, bx);
        pg8::EpiSwiglu E{HID, FF, SSQ1, 1.f / D, EPS};
        pg8::gemm_phase<pg8::EpiSwiglu, pg8::StaticOrder, PG8_ALIGN, PG8_SP2>(lds + RING_OFF, g, S, E);
        if (BOTH(4)) GRID_BAR();
    }

    if (IN(5)) {
        pg8::Gemm g{HID, WDN, M, D, FF}; pg8::StaticOrder S; S.init(M, D, G, bx);
        pg8::EpiResid<false> E{out, out, nullptr, SSQ2, D};
        pg8::gemm_phase<pg8::EpiResid<false>, pg8::StaticOrder, PG8_ALIGN, PG8_SP2>(lds + RING_OFF, g, S, E);
        if (BOTH(5)) GRID_BAR();
    }

    if (IN(6)) {
        for (int m = gw; m < M; m += NGW) {
            const GAS f32x4* p = (const GAS f32x4*)(SSQ2 + (size_t)m * 16); const f32x4 a = p[0], b = p[1], c = p[2], d = p[3];
            const f32x4 t = (a + b) + (c + d); const float rstd = rsqrtf(((t[0] + t[1]) + (t[2] + t[3])) * (1.f / D) + EPS);
            GAS f32x4* xr = (GAS f32x4*)(out + (size_t)m * D) + lane; const GAS f32x4* gr = (const GAS f32x4*)normf_g + lane;
#pragma unroll
            for (int j = 0; j < 4; ++j) { const f32x4 v = xr[64 * j], gg = gr[64 * j]; xr[64 * j] = v * rstd * gg; }
        }
    }
#undef IN
#undef BOTH
}

extern "C" void kernel_launch(void* const* d_in, const int* in_sizes, int n_in, void* d_out, int out_size, void* d_ws, size_t ws_size, hipStream_t stream) {
    static int grid = 0;
    if (grid == 0) {
        if (n_in != 13 || in_sizes[0] != M * D || out_size != M * D || ws_size < WS_END) { fprintf(stderr, "kernel_launch: unexpected shapes (n_in %d, in0 %d, out %d, ws %zu); nothing launched\n", n_in, n_in > 0 ? in_sizes[0] : -1, out_size, ws_size); grid = -1; return; }
        int dev = 0, cus = 0, per_cu = 0;
        if (hipGetDevice(&dev) != hipSuccess || hipDeviceGetAttribute(&cus, hipDeviceAttributeMultiprocessorCount, dev) != hipSuccess) { fprintf(stderr, "kernel_launch: device query failed\n"); grid = -1; return; }
        if (hipFuncSetAttribute((const void*)hymba_fwd, hipFuncAttributeMaxDynamicSharedMemorySize, LDS_BYTES) != hipSuccess) { fprintf(stderr, "kernel_launch: hipFuncSetAttribute failed\n"); grid = -1; return; }
        if (hipOccupancyMaxActiveBlocksPerMultiprocessor(&per_cu, (const void*)hymba_fwd, NWAVES * 64, LDS_BYTES) != hipSuccess || per_cu < 1)
            fprintf(stderr, "kernel_launch: note: occupancy query reports %d workgroups per CU\n", per_cu);
        (void)hipGetLastError();
        grid = cus;
    }
    if (grid < 0) return;
    if (hipMemsetAsync((char*)d_ws + WS_CTL, 0, CTL_ZERO_BYTES, stream) != hipSuccess) { fprintf(stderr, "kernel_launch: hipMemsetAsync failed\n"); return; }
    Args a{};
    for (int i = 0; i < 13; ++i) a.in[i] = (const float*)d_in[i];
    a.out = (float*)d_out; a.ws = (unsigned char*)d_ws;
    for (int li = 0; li < N_LAUNCHES; ++li) {
        a.ph_lo = (N_LAUNCHES == 1) ? 0 : li; a.ph_hi = (N_LAUNCHES == 1) ? N_PHASES : li + 1;
        hipLaunchKernelGGL(hymba_fwd, dim3(grid), dim3(NWAVES * 64), LDS_BYTES, stream, a);
        const hipError_t le = hipPeekAtLastError();
        if (le != hipSuccess) { fprintf(stderr, "kernel_launch: launch %d failed: %s\n", li, hipGetErrorName(le)); break; }
    }
}
```

```cpp
#include <hip/hip_runtime.h>
#include <cstdio>
#include <cstdint>
namespace pg8 {
#define PG8_LAS __attribute__((address_space(3)))
typedef unsigned short bf16_t;
typedef short bf16x8 __attribute__((ext_vector_type(8)));
typedef float f32x4 __attribute__((ext_vector_type(4)));
typedef unsigned u32x4 __attribute__((ext_vector_type(4)));
constexpr int BM = 256, BK = 64, HALF = 128, HTB = HALF * BK * 2  , STAGE_BYTES = 8 * HTB, NXCD = 8, WGM = 8;

__host__ __device__ __forceinline__ int lds_byte(int r, int c) { const int st = (r >> 4) * 2 + (c >> 5), rr = r & 15, cc = c & 31, ob = rr * 64 + cc * 2; return st * 1024 + (ob ^ (((ob >> 9) & 1) << 5)); }
__host__ __device__ __forceinline__ void stage_rc(int b, int& R, int& C) { const int st = b / 1024, sb = b % 1024, swz = sb ^ (((sb >> 9) & 1) << 5); R = (st >> 1) * 16 + swz / 64; C = (st & 1) * 32 + (swz % 64) / 2; }
__host__ __device__ __forceinline__ int perm32(int rho) { const int n = rho >> 4, i = rho & 15; return 8 * (i >> 2) + 4 * n + (i & 3); }

struct Unit { int pm, pn; };
struct Gemm { const bf16_t* A; const bf16_t* Bt; int M, N, K; };

struct StaticOrder {
    int nM, nN, nwg, G, c;
    __host__ __device__ void init(int M, int N, int G_, int c_) { nM = M / BM; nN = N / BM; nwg = nM * nN; G = G_; c = c_; }
    __host__ __device__ bool next(int i, Unit& u) const {
        const long L = (long)i * G + c; if (L >= nwg) return false;
        int wgid = (int)L; { const int q = nwg / NXCD, r = nwg % NXCD, xcd = wgid % NXCD, off = wgid / NXCD; wgid = (xcd < r ? xcd * (q + 1) : r * (q + 1) + (xcd - r) * q) + off; }
        const int nig = WGM * nN, gid = wgid / nig, fm = gid * WGM, gsz = (nM - fm) < WGM ? (nM - fm) : WGM;
        u.pm = fm + ((wgid % nig) % gsz); u.pn = (wgid % nig) / gsz; return true;
    }
    __device__ __forceinline__ void a_ready(const Unit&) const {}
    __device__ __forceinline__ void done(const Unit&) const {}
};

__device__ __forceinline__ unsigned cvt_pk_bf16(float lo, float hi) { unsigned r; asm volatile("v_cvt_pk_bf16_f32 %0, %1, %2" : "=v"(r) : "v"(lo), "v"(hi)); return r; }

__device__ __forceinline__ float fast_silu(float g) { return g * __builtin_amdgcn_rcpf(1.0f + __builtin_amdgcn_exp2f(-1.44269504089f * g)); }

struct EpiStoreBf16 {
    static constexpr bool PERM = true, AFTER_DRAIN = false;
    bf16_t* O; int ldc;
    __device__ __forceinline__ void operator()(const f32x4 (&acc)[2][2][4][2], const Unit& u, int wr, int wc, int fr, int fq) const {
        const int row0 = u.pm * BM + wr * 64 + fr, col0 = u.pn * BM + wc * 32 + 8 * fq;
#pragma unroll
        for (int ai = 0; ai < 2; ++ai)
#pragma unroll
            for (int m = 0; m < 4; ++m) { bf16_t* rowp = O + (size_t)(row0 + ai * HALF + m * 16) * ldc + col0;
#pragma unroll
                for (int bj = 0; bj < 2; ++bj) { const f32x4 v0 = acc[ai][bj][m][0], v1 = acc[ai][bj][m][1];
                    u32x4 w; w.x = cvt_pk_bf16(v0[0], v0[1]); w.y = cvt_pk_bf16(v0[2], v0[3]); w.z = cvt_pk_bf16(v1[0], v1[1]); w.w = cvt_pk_bf16(v1[2], v1[3]);
                    *(u32x4*)(rowp + bj * HALF) = w; } }
    }
};
template <bool WITH_BF16> struct EpiResid {
    static constexpr bool PERM = true, AFTER_DRAIN = false;
    const float* base; float* out; bf16_t* xb; float* ssq; int ldc;
    __device__ __forceinline__ void operator()(const f32x4 (&acc)[2][2][4][2], const Unit& u, int wr, int wc, int fr, int fq) const {
        const int row0 = u.pm * BM + wr * 64 + fr, col0 = u.pn * BM + wc * 32 + 8 * fq;
#pragma unroll
        for (int ai = 0; ai < 2; ++ai)
#pragma unroll
            for (int m = 0; m < 4; ++m) { const int row = row0 + ai * HALF + m * 16; const size_t off = (size_t)row * ldc + col0; float s = 0.f;
#pragma unroll
                for (int bj = 0; bj < 2; ++bj) {
                    const f32x4 b0 = *(const f32x4*)(base + off + bj * HALF), b1 = *(const f32x4*)(base + off + bj * HALF + 4);
                    const f32x4 v0 = acc[ai][bj][m][0] + b0, v1 = acc[ai][bj][m][1] + b1;
                    *(f32x4*)(out + off + bj * HALF) = v0; *(f32x4*)(out + off + bj * HALF + 4) = v1;
                    s += (v0[0] * v0[0] + v0[1] * v0[1]) + (v0[2] * v0[2] + v0[3] * v0[3]) + (v1[0] * v1[0] + v1[1] * v1[1]) + (v1[2] * v1[2] + v1[3] * v1[3]);
                    if (WITH_BF16) { u32x4 w; w.x = cvt_pk_bf16(v0[0], v0[1]); w.y = cvt_pk_bf16(v0[2], v0[3]); w.z = cvt_pk_bf16(v1[0], v1[1]); w.w = cvt_pk_bf16(v1[2], v1[3]);
                        *(u32x4*)(xb + off + bj * HALF) = w; } }
                s += __shfl_xor(s, 16); s += __shfl_xor(s, 32);
                if (fq == 0) ssq[(size_t)row * 16 + u.pn * 4 + wc] = s; }
    }
};
struct EpiSwiglu {
    static constexpr bool PERM = true, AFTER_DRAIN = false;
    bf16_t* H; int ldh; const float* ssq; float inv_n, eps;
    __device__ __forceinline__ void operator()(const f32x4 (&acc)[2][2][4][2], const Unit& u, int wr, int wc, int fr, int fq) const {
        const int row0 = u.pm * BM + wr * 64 + fr, col0 = u.pn * HALF + wc * 32 + 8 * fq;
#pragma unroll
        for (int ai = 0; ai < 2; ++ai)
#pragma unroll
            for (int m = 0; m < 4; ++m) { const int row = row0 + ai * HALF + m * 16;
                const f32x4* p = (const f32x4*)(ssq + (size_t)row * 16); const f32x4 a = p[0], b = p[1], c = p[2], d = p[3];
                const f32x4 t = (a + b) + (c + d); const float rstd = rsqrtf(((t[0] + t[1]) + (t[2] + t[3])) * inv_n + eps);
                float hv[8];
#pragma unroll
                for (int n = 0; n < 2; ++n)
#pragma unroll
                    for (int e = 0; e < 4; ++e) { const float g = acc[ai][0][m][n][e] * rstd, uu = acc[ai][1][m][n][e] * rstd; hv[n * 4 + e] = fast_silu(g) * uu; }
                u32x4 w; w.x = cvt_pk_bf16(hv[0], hv[1]); w.y = cvt_pk_bf16(hv[2], hv[3]); w.z = cvt_pk_bf16(hv[4], hv[5]); w.w = cvt_pk_bf16(hv[6], hv[7]);
                *(u32x4*)(H + (size_t)row * ldh + col0) = w; }
    }
};

template <class Epi, class Sched, bool ALIGN_EPI = false, bool SP2 = false>
__device__ __forceinline__ void gemm_phase(PG8_LAS unsigned char* lds, const Gemm g, const Sched& S, const Epi& E) {
    const int tid = threadIdx.x, wid = __builtin_amdgcn_readfirstlane(tid >> 6), lane = tid & 63, wr = wid >> 2, wc = wid & 3, fr = lane & 15, fq = lane >> 4;
    const int K = g.K, nt = K / BK;
    unsigned voffA[2], voffB[2];
#pragma unroll
    for (int i = 0; i < 2; ++i) { int R, C; stage_rc(tid * 16 + i * 8192, R, C); const int Rb = Epi::PERM ? ((R & ~31) + perm32(R & 31)) : R;
        voffA[i] = (unsigned)(R * K + C) * 2u; voffB[i] = (unsigned)(Rb * K + C) * 2u; }
    const size_t kstep = (size_t)(BK * 2);
    const size_t hstep = (size_t)HALF * K * 2;
    const size_t tstep = 2 * hstep;
    const unsigned ldsw = (unsigned)wid * 1024u;
    const int aoff = lds_byte(wr * 64 + fr, fq * 8), boff = lds_byte(wc * 32 + fr, fq * 8);
#define PG8_SA(b, h) (((b) * 2 + (h)) * HTB)
#define PG8_SB(b, h) ((4 + (b) * 2 + (h)) * HTB)
#define PG8_STAGE(bufoff, gbase, voff) do { _Pragma("unroll") for (int _i = 0; _i < 2; ++_i) \
        __builtin_amdgcn_global_load_lds((const unsigned*)((const char*)(gbase) + (voff)[_i]), (PG8_LAS unsigned*)(lds + (bufoff) + ldsw + _i * 8192), 16, 0, 0); } while (0)
#define PG8_LDA(dst, b, h) do { _Pragma("unroll") for (int m = 0; m < 4; ++m) _Pragma("unroll") for (int k = 0; k < 2; ++k) dst[m][k] = *(const PG8_LAS bf16x8*)(lds + PG8_SA(b, h) + aoff + m * 2048 + k * 1024); } while (0)
#define PG8_LDB(dst, b, h) do { _Pragma("unroll") for (int n = 0; n < 2; ++n) _Pragma("unroll") for (int k = 0; k < 2; ++k) dst[n][k] = *(const PG8_LAS bf16x8*)(lds + PG8_SB(b, h) + boff + n * 2048 + k * 1024); } while (0)
#define PG8_MMA(ai, bj, At, Bt) do { __builtin_amdgcn_s_setprio(1); _Pragma("unroll") for (int m = 0; m < 4; ++m) _Pragma("unroll") for (int n = 0; n < 2; ++n) _Pragma("unroll") for (int k = 0; k < 2; ++k) \
        acc[ai][bj][m][n] = __builtin_amdgcn_mfma_f32_16x16x32_bf16(Bt[n][k], At[m][k], acc[ai][bj][m][n], 0, 0, 0); __builtin_amdgcn_s_setprio(0); } while (0)
#define PG8_WAIT_V(n) asm volatile("s_waitcnt vmcnt(" #n ")" ::: "memory")
#define PG8_WAIT_L(n) asm volatile("s_waitcnt lgkmcnt(" #n ")" ::: "memory")
#define PG8_BAR __builtin_amdgcn_s_barrier()
#define PG8_SCHED __builtin_amdgcn_sched_barrier(0)
    Unit cur, nxt; int ui = 0;
    if (!S.next(0, cur)) return;
    f32x4 acc[2][2][4][2];
#pragma unroll
    for (int a = 0; a < 2; ++a)
#pragma unroll
        for (int b = 0; b < 2; ++b)
#pragma unroll
            for (int m = 0; m < 4; ++m)
#pragma unroll
                for (int n = 0; n < 2; ++n) acc[a][b][m][n] = (f32x4){0.f, 0.f, 0.f, 0.f};
    bf16x8 At[4][2], B0[2][2], B1[2][2];
    const char* cA = (const char*)g.A + (size_t)cur.pm * tstep; const char* cB = (const char*)g.Bt + (size_t)cur.pn * tstep;
    S.a_ready(cur);
    if constexpr (SP2) {
        PG8_STAGE(PG8_SB(0, 0), cB, voffB); PG8_STAGE(PG8_SB(0, 1), cB + hstep, voffB); PG8_STAGE(PG8_SA(0, 0), cA, voffA); PG8_STAGE(PG8_SA(0, 1), cA + hstep, voffA);
        if (wr == 1) PG8_BAR;
        PG8_WAIT_V(2); PG8_BAR;
        PG8_STAGE(PG8_SB(1, 0), cB + kstep, voffB); PG8_STAGE(PG8_SA(1, 0), cA + kstep, voffA); PG8_STAGE(PG8_SB(1, 1), cB + hstep + kstep, voffB);
        PG8_WAIT_V(6); PG8_BAR;
    } else {
        PG8_STAGE(PG8_SB(0, 0), cB, voffB); PG8_STAGE(PG8_SA(0, 0), cA, voffA); PG8_STAGE(PG8_SB(0, 1), cB + hstep, voffB); PG8_STAGE(PG8_SA(0, 1), cA + hstep, voffA);
        if (wr == 1) PG8_BAR;
        PG8_WAIT_V(4); PG8_BAR;
        PG8_STAGE(PG8_SB(1, 0), cB + kstep, voffB); PG8_STAGE(PG8_SA(1, 0), cA + kstep, voffA); PG8_STAGE(PG8_SB(1, 1), cB + hstep + kstep, voffB);
        PG8_WAIT_V(6); PG8_BAR;
    }
    for (;;) {
        const bool has_next = S.next(ui + 1, nxt);
        const char* nA = has_next ? (const char*)g.A + (size_t)nxt.pm * tstep : cA; const char* nB = has_next ? (const char*)g.Bt + (size_t)nxt.pn * tstep : cB;
        for (int t = 0; t < nt; t += 2) {
            const bool last = (t == nt - 2);
            const char* a1 = cA + (size_t)(t + 1) * kstep;
            const char* a2 = last ? nA : cA + (size_t)(t + 2) * kstep; const char* b2 = last ? nB : cB + (size_t)(t + 2) * kstep;
            const char* a3 = a2 + kstep; const char* b3 = b2 + kstep;
            if (last && has_next) S.a_ready(nxt);
            if constexpr (SP2) {
            PG8_LDB(B0, 0, 0); PG8_LDB(B1, 0, 1); PG8_SCHED; PG8_LDA(At, 0, 0); PG8_STAGE(PG8_SA(1, 1), a1 + hstep, voffA);
            PG8_WAIT_V(8); PG8_WAIT_L(0); PG8_BAR; PG8_MMA(0, 0, At, B0); PG8_MMA(0, 1, At, B1); PG8_BAR; PG8_SCHED;
            PG8_LDA(At, 0, 1); PG8_STAGE(PG8_SB(0, 0), b2, voffB); PG8_STAGE(PG8_SB(0, 1), b2 + hstep, voffB); PG8_STAGE(PG8_SA(0, 0), a2, voffA);
            PG8_WAIT_V(8); PG8_WAIT_L(0); PG8_BAR; PG8_MMA(1, 0, At, B0); PG8_MMA(1, 1, At, B1); PG8_BAR; PG8_SCHED;
            PG8_LDB(B0, 1, 0); PG8_LDB(B1, 1, 1); PG8_SCHED; PG8_LDA(At, 1, 0); PG8_STAGE(PG8_SA(0, 1), a2 + hstep, voffA);
            PG8_WAIT_V(8); PG8_WAIT_L(0); PG8_BAR; PG8_MMA(0, 0, At, B0); PG8_MMA(0, 1, At, B1); PG8_BAR; PG8_SCHED;
            PG8_LDA(At, 1, 1); PG8_STAGE(PG8_SB(1, 0), b3, voffB); PG8_STAGE(PG8_SB(1, 1), b3 + hstep, voffB); PG8_STAGE(PG8_SA(1, 0), a3, voffA);
            PG8_WAIT_V(8); PG8_WAIT_L(0); PG8_BAR; PG8_MMA(1, 0, At, B0); PG8_MMA(1, 1, At, B1); PG8_BAR; PG8_SCHED;
            } else {
            PG8_LDB(B0, 0, 0); PG8_SCHED; PG8_LDA(At, 0, 0); PG8_STAGE(PG8_SA(1, 1), a1 + hstep, voffA);
            PG8_WAIT_L(8); PG8_BAR; PG8_WAIT_L(0); PG8_MMA(0, 0, At, B0); PG8_BAR; PG8_SCHED;
            PG8_LDB(B1, 0, 1); PG8_STAGE(PG8_SB(0, 0), b2, voffB);
            PG8_BAR; PG8_WAIT_L(0); PG8_MMA(0, 1, At, B1); PG8_BAR;
            PG8_LDA(At, 0, 1); PG8_STAGE(PG8_SA(0, 0), a2, voffA);
            PG8_BAR; PG8_WAIT_L(0); PG8_MMA(1, 0, At, B0); PG8_BAR; PG8_SCHED;
            PG8_STAGE(PG8_SB(0, 1), b2 + hstep, voffB);
            PG8_WAIT_V(6); PG8_BAR; PG8_MMA(1, 1, At, B1); PG8_BAR;
            PG8_LDB(B0, 1, 0); PG8_SCHED; PG8_LDA(At, 1, 0); PG8_STAGE(PG8_SA(0, 1), a2 + hstep, voffA);
            PG8_WAIT_L(8); PG8_BAR; PG8_WAIT_L(0); PG8_MMA(0, 0, At, B0); PG8_BAR; PG8_SCHED;
            PG8_LDB(B1, 1, 1); PG8_STAGE(PG8_SB(1, 0), b3, voffB);
            PG8_BAR; PG8_WAIT_L(0); PG8_MMA(0, 1, At, B1); PG8_BAR;
            PG8_LDA(At, 1, 1); PG8_STAGE(PG8_SA(1, 0), a3, voffA);
            PG8_BAR; PG8_WAIT_L(0); PG8_MMA(1, 0, At, B0); PG8_BAR; PG8_SCHED;
            PG8_STAGE(PG8_SB(1, 1), b3 + hstep, voffB);
            PG8_WAIT_V(6); PG8_BAR; PG8_MMA(1, 1, At, B1); PG8_BAR;
            }
        }
        if constexpr (ALIGN_EPI) { if (wr == 0) PG8_BAR; }
        if constexpr (!Epi::AFTER_DRAIN) { E(acc, cur, wr, wc, fr, fq); S.done(cur); }
        if (!has_next) break;
#pragma unroll
        for (int a = 0; a < 2; ++a)
#pragma unroll
            for (int b = 0; b < 2; ++b)
#pragma unroll
                for (int m = 0; m < 4; ++m)
#pragma unroll
                    for (int n = 0; n < 2; ++n) acc[a][b][m][n] = (f32x4){0.f, 0.f, 0.f, 0.f};
        cur = nxt; cA = nA; cB = nB; ++ui;
        if constexpr (ALIGN_EPI) { if (wr == 1) PG8_BAR; }
    }
    PG8_WAIT_V(0);
    if constexpr (!ALIGN_EPI) { if (wr == 0) PG8_BAR; }
    PG8_BAR;
    if constexpr (Epi::AFTER_DRAIN) { E.fused(acc, cur, wr, wc, fr, fq, lds, wid, lane); S.done(cur); }
#undef PG8_SA
#undef PG8_SB
#undef PG8_STAGE
#undef PG8_LDA
#undef PG8_LDB
#undef PG8_MMA
#undef PG8_WAIT_V
#undef PG8_WAIT_L
#undef PG8_BAR
#undef PG8_SCHED
}
}

#ifndef PG8_SP2
#define PG8_SP2 true
#endif
#ifndef PG8_ALIGN
#define PG8_ALIGN true
#endif

#define GAS __attribute__((address_space(1)))
#define LAS __attribute__((address_space(3)))
typedef unsigned short bf16;
typedef unsigned v4u __attribute__((ext_vector_type(4)));
typedef float f32x4 __attribute__((ext_vector_type(4)));
typedef short bf16x8 __attribute__((ext_vector_type(8)));
typedef GAS unsigned gu32;
typedef GAS unsigned long long gu64;
#define RLX_AGENT __ATOMIC_RELAXED, __HIP_MEMORY_SCOPE_AGENT
#define LDS_WAIT() asm volatile("s_waitcnt lgkmcnt(0)" ::: "memory")
#define VM_WAIT() asm volatile("s_waitcnt vmcnt(0)" ::: "memory")
__device__ __forceinline__ unsigned long long rt() { return __builtin_amdgcn_s_memrealtime(); }
__device__ __forceinline__ unsigned f2bf(float f) { unsigned u = __builtin_bit_cast(unsigned, f); return (u + 0x7fffu + ((u >> 16) & 1u)) >> 16; }
__device__ __forceinline__ unsigned pk2(float lo, float hi) { return f2bf(lo) | (f2bf(hi) << 16); }

#define XB_TMO      128
#define XB_XCNT(j)  (256  + 64 * (j))
#define XB_XSUB(j)  (1280 + 64 * (j))
#define XB_XGEN(j)  (2304 + 64 * (j))
#define XB_TOP      3328
#define XB_TOPGEN   3392
#define XCD_BAR_WORDS 3456
#define XB_SPIN_CAP (1u << 18)

__device__ __forceinline__ unsigned xb_ld(unsigned* p)              { return __hip_atomic_load(p, __ATOMIC_RELAXED, __HIP_MEMORY_SCOPE_AGENT); }
__device__ __forceinline__ unsigned xb_add(unsigned* p, unsigned v) { return __hip_atomic_fetch_add(p, v, __ATOMIC_RELAXED, __HIP_MEMORY_SCOPE_AGENT); }
__device__ __forceinline__ unsigned xb_xcc_id() { return (unsigned)__builtin_amdgcn_s_getreg((3 << 11) | 20) & 0xFu; }
#define XB_SPIN(cond, bar) do { unsigned _sp = 0; while (cond) { __builtin_amdgcn_s_sleep(1); \
    if ((++_sp & 255u) == 0u) { if (xb_ld(&(bar)[XB_TMO])) break; if (_sp > XB_SPIN_CAP) { atomicAdd(&(bar)[XB_TMO], 1u); break; } } } } while (0)

struct XcdBarrier {
    unsigned* bar; unsigned x;
    volatile LAS unsigned* st;
};

__device__ __forceinline__ XcdBarrier xcd_barrier_post(unsigned* bar, volatile LAS unsigned* st) {
    XcdBarrier b; b.bar = bar; b.x = xb_xcc_id(); b.st = st;
    if (threadIdx.x == 0) (void)xb_add(&bar[XB_XCNT(b.x)], 1u);
    return b;
}
__device__ __forceinline__ void xcd_barrier_complete(unsigned* bar, unsigned x, unsigned& nloc, unsigned& nx) {
    const unsigned G = gridDim.x * gridDim.y * gridDim.z;
    unsigned sum, cnt, mine, sp = 0u;
    for (;;) {
        sum = 0u; cnt = 0u; mine = 0u;
#pragma unroll
        for (unsigned j = 0; j < 16; ++j) { const unsigned c = xb_ld(&bar[XB_XCNT(j)]); sum += c; cnt += (c > 0u) ? 1u : 0u; mine = (j == x) ? c : mine; }
        if (sum == G) break;
        __builtin_amdgcn_s_sleep(1);
        if ((++sp & 255u) == 0u) { if (xb_ld(&bar[XB_TMO])) break; if (sp > XB_SPIN_CAP) { atomicAdd(&bar[XB_TMO], 1u); break; } }
    }
    nloc = mine > 0u ? mine : 1u; nx = cnt > 0u ? cnt : 1u;
}

__device__ __forceinline__ void xcd_barrier(const XcdBarrier& b) {
    asm volatile("s_waitcnt vmcnt(0)" ::: "memory");
    __syncthreads();
    if (threadIdx.x == 0) {
        unsigned* bar = b.bar;
        __builtin_amdgcn_s_waitcnt(0);
        unsigned nloc = b.st[0], nx = b.st[1];
        if (nloc == 0u) { xcd_barrier_complete(bar, b.x, nloc, nx); b.st[0] = nloc; b.st[1] = nx; }
        const unsigned old = xb_add(&bar[XB_XSUB(b.x)], 1u);
        const unsigned gen = old / nloc;
        if (old + 1u == (gen + 1u) * nloc) {
            __builtin_amdgcn_fence(__ATOMIC_RELEASE, "agent");
            asm volatile("s_waitcnt vmcnt(0)" ::: "memory");
            const unsigned og = xb_add(&bar[XB_TOP], 1u);
            const unsigned tg = og / nx;
            if (og + 1u == (tg + 1u) * nx) xb_add(&bar[XB_TOPGEN], 1u);
            else XB_SPIN(xb_ld(&bar[XB_TOPGEN]) == tg, bar);
            __builtin_amdgcn_fence(__ATOMIC_ACQUIRE, "agent");
            xb_add(&bar[XB_XGEN(b.x)], 1u);
            asm volatile("s_waitcnt vmcnt(0)" ::: "memory");
        } else {
            XB_SPIN(xb_ld(&bar[XB_XGEN(b.x)]) == gen, bar);
            __builtin_amdgcn_fence(__ATOMIC_ACQUIRE, "agent");
            asm volatile("s_waitcnt vmcnt(0)" ::: "memory");
        }
    }
    __syncthreads();
}

constexpr int NWAVES = 8;
#ifndef MK_N_LAUNCHES
#define MK_N_LAUNCHES 1
#endif
constexpr int N_LAUNCHES = MK_N_LAUNCHES;
constexpr int N_PHASES = 7;
constexpr int BATCH = 16, SEQ = 2048, D = 1024, M = BATCH * SEQ;
constexpr int GH = 4, GDK = 64, GDV = 128, CHUNK = 64, RANK = 16, CONVW = 512, FF = 2816;
constexpr int IN_COLS = 3088;
constexpr int SRC_A = 1536, SRC_CB = 1552;
constexpr int NP = 3328;
constexpr int PC_Q = 0, PC_K = 256, PC_V = 512, PC_G = 1024, PC_GATE = 1536, PC_CB = 1792, PC_CC = 2304, PC_CH = 2816;
constexpr int NGU = 2 * FF;
constexpr float EPS = 1e-6f;

constexpr size_t MiB = 1u << 20;
constexpr size_t WS_CTL = 0, CTL_ZERO_BYTES = 1 * MiB;
constexpr size_t WS_WIN = 2 * MiB, WS_WOUT = 10 * MiB, WS_WGU = 12 * MiB, WS_WDN = 24 * MiB;
constexpr size_t WS_SSQ1 = 30 * MiB, WS_SSQ2 = 32 * MiB;
constexpr size_t WS_XN = 64 * MiB;
constexpr size_t WS_PROJ = 128 * MiB;
constexpr size_t WS_MIX = 336 * MiB;
constexpr size_t WS_END = 400 * MiB;
static_assert(WS_WIN + (size_t)NP * D * 2 <= WS_WOUT && WS_WOUT + (size_t)D * D * 2 <= WS_WGU && WS_WGU + (size_t)NGU * D * 2 <= WS_WDN && WS_WDN + (size_t)D * FF * 2 <= WS_SSQ1, "weights");
static_assert(WS_SSQ1 + (size_t)M * 16 * 4 <= WS_SSQ2 && WS_SSQ2 + (size_t)M * 16 * 4 <= WS_XN && WS_XN + (size_t)M * D * 2 <= WS_PROJ && WS_PROJ + (size_t)M * NP * 2 <= WS_MIX && WS_PROJ + (size_t)M * FF * 2 <= WS_MIX && WS_MIX + (size_t)M * D * 2 <= WS_END, "d_ws map");
constexpr int CW_BAR = 4096;

constexpr int RING_OFF = 0, RING_BYTES = 131072;
constexpr int LDSCTL_OFF = RING_BYTES, MISC_OFF = LDSCTL_OFF + 320;
constexpr int LDS_BYTES = 147456;
static_assert(MISC_OFF + 128 <= LDS_BYTES, "LDS map");

__device__ __forceinline__ float wave_sum(float v) {
#pragma unroll
    for (int o = 1; o < 64; o <<= 1) v += __shfl_xor(v, o);
    return v;
}
__device__ __forceinline__ float bf_lo(unsigned w) { return __builtin_bit_cast(float, w << 16); }
__device__ __forceinline__ float bf_hi(unsigned w) { return __builtin_bit_cast(float, w & 0xffff0000u); }

__device__ __forceinline__ void p0_transpose_item(const float* W, int ld, int K, bf16* WT, int row_off, int kb, int nb, const float* kscale, float scale, LAS float* scr, int lane) {
    const int k0 = 64 * kb, n0 = 32 * nb;
#pragma unroll 8
    for (int i = 0; i < 32; ++i) { const int kk = 2 * i + (lane >> 5); float v = W[(size_t)(k0 + kk) * ld + n0 + (lane & 31)] * scale; if (kscale) v *= kscale[k0 + kk]; scr[kk * 33 + (lane & 31)] = v; }
    LDS_WAIT(); asm volatile("" ::: "memory");
    const int c = lane & 7;
#pragma unroll
    for (int j = 0; j < 4; ++j) { const int n = (lane >> 3) + 8 * j; const LAS float* s = scr + (8 * c) * 33 + n;
        v4u o; o.x = pk2(s[0 * 33], s[1 * 33]); o.y = pk2(s[2 * 33], s[3 * 33]); o.z = pk2(s[4 * 33], s[5 * 33]); o.w = pk2(s[6 * 33], s[7 * 33]);
        *(GAS v4u*)(WT + (size_t)(row_off + n0 + n) * K + k0 + 8 * c) = o; }
    LDS_WAIT(); asm volatile("" ::: "memory");
}
__device__ __forceinline__ void p0_gate_item(const float* w_in, const float* wgu, bf16* WT, int kb, int jb, int lane) {
    const int k = 64 * kb + lane; float a[RANK];
#pragma unroll
    for (int r = 0; r < RANK; ++r) a[r] = w_in[(size_t)k * IN_COLS + SRC_A + r];
#pragma unroll
    for (int jj = 0; jj < 8; ++jj) { const int j = 8 * jb + jj; float s = 0.f;
#pragma unroll
        for (int r = 0; r < RANK; ++r) s += a[r] * wgu[r * 256 + j];
        WT[(size_t)(PC_GATE + j) * D + k] = (bf16)f2bf(s); }
}
__device__ __forceinline__ void rms_row_to_bf16(const float* xrow, const float* g, bf16* orow, int lane) {
    const GAS f32x4* xr = (const GAS f32x4*)xrow + lane; const GAS f32x4* gr = (const GAS f32x4*)g + lane;
    f32x4 v[4]; float s = 0.f;
#pragma unroll
    for (int j = 0; j < 4; ++j) { v[j] = xr[64 * j]; s += (v[j].x * v[j].x + v[j].y * v[j].y) + (v[j].z * v[j].z + v[j].w * v[j].w); }
    const float rstd = rsqrtf(wave_sum(s) * (1.f / D) + EPS);
    GAS unsigned long long* o8 = (GAS unsigned long long*)orow + lane;
#pragma unroll
    for (int j = 0; j < 4; ++j) { const f32x4 gg = gr[64 * j]; o8[64 * j] = (unsigned long long)pk2(v[j].x * rstd * gg.x, v[j].y * rstd * gg.y) | ((unsigned long long)pk2(v[j].z * rstd * gg.z, v[j].w * rstd * gg.w) << 32); }
}

typedef short v4i16_t __attribute__((ext_vector_type(4)));
typedef float f32x2_t __attribute__((ext_vector_type(2))); typedef __bf16 bf16x2_t __attribute__((ext_vector_type(2)));
typedef unsigned v2u __attribute__((ext_vector_type(2)));
__device__ __forceinline__ unsigned cvtpk_s(float lo, float hi) { f32x2_t v = {lo, hi}; bf16x2_t b = __builtin_convertvector(v, bf16x2_t); return __builtin_bit_cast(unsigned, b); }
__device__ __forceinline__ v4i16_t ds_tr(const LAS unsigned char* p) { return __builtin_amdgcn_ds_read_tr16_b64_v4i16((LAS v4i16_t*)p); }
__device__ __forceinline__ bf16x8 pack8(f32x4 lo, f32x4 hi) { v4u w; w.x = cvtpk_s(lo[0], lo[1]); w.y = cvtpk_s(lo[2], lo[3]); w.z = cvtpk_s(hi[0], hi[1]); w.w = cvtpk_s(hi[2], hi[3]); return __builtin_bit_cast(bf16x8, w); }
__device__ __forceinline__ f32x4 mfma16(bf16x8 a, bf16x8 b, f32x4 c) { return __builtin_amdgcn_mfma_f32_16x16x32_bf16(a, b, c, 0, 0, 0); }
constexpr int GQ_STR = 144, GS_STR = 160, GV_STR = 288, GO_STR = 132;
constexpr int GL_QI = 0, GL_KI = GL_QI + 64 * GQ_STR, GL_KS = GL_KI + 64 * GQ_STR, GL_V = GL_KS + 64 * GS_STR, GL_O = GL_V + 64 * GV_STR, GL_WT = GL_O + 64 * GO_STR * 4, GL_DEC = GL_WT + 8 * 64 * 4, GL_END = GL_DEC + 256;
static_assert(GL_END <= RING_BYTES && GL_KI % 16 == 0 && GL_KS % 16 == 0 && GL_V % 16 == 0 && GL_O % 16 == 0 && GL_WT % 16 == 0 && GL_DEC % 16 == 0, "GLA LDS map");
#define GLA_LOADS(n_, Z, Q, K, V0, V1, G0, G1) do { const bf16* pr_ = PROJ + (rowbase + (size_t)(n_) * CHUNK + t) * NP; \
    Z = *(const GAS v4u*)(pr_ + PC_GATE + h * 64 + c8); Q = *(const GAS v4u*)(pr_ + PC_Q + h * 64 + c8); K = *(const GAS v4u*)(pr_ + PC_K + h * 64 + c8); \
    V0 = *(const GAS v4u*)(pr_ + PC_V + h * 128 + c8); V1 = *(const GAS v4u*)(pr_ + PC_V + h * 128 + 64 + c8); \
    G0 = *(const GAS v4u*)(pr_ + PC_G + h * 128 + 2 * c8); G1 = *(const GAS v4u*)(pr_ + PC_G + h * 128 + 2 * c8 + 8); } while (0)
__device__ __forceinline__ void gla_unit(LAS unsigned char* lds, const bf16* PROJ, bf16* MIX, const float* b_gate, const float* gla_g, int b, int h, int tid, int lane, int wave) {
    const int t = tid >> 3, cg = tid & 7, c8 = cg * 8;
    const int fr = lane & 15, fq = lane >> 4, trq = fr >> 2, trp = fr & 3;
    const size_t rowbase = (size_t)b * SEQ;
    float bg[8], gg[16];
#pragma unroll
    for (int e = 0; e < 8; ++e) bg[e] = b_gate[h * 64 + c8 + e];
#pragma unroll
    for (int e = 0; e < 16; ++e) gg[e] = gla_g[2 * c8 + e];
    f32x4 Sacc[4];
#pragma unroll
    for (int m = 0; m < 4; ++m) Sacc[m] = (f32x4){0.f, 0.f, 0.f, 0.f};
    LAS float* Lo = (LAS float*)(lds + GL_O);
    v4u cz, cq, ck, cv0, cv1, cg0, cg1;
    GLA_LOADS(0, cz, cq, ck, cv0, cv1, cg0, cg1);
    for (int n = 0; n < SEQ / CHUNK; ++n) {
        float cs[8];
        { const unsigned zw[4] = {cz.x, cz.y, cz.z, cz.w};
#pragma unroll
          for (int e = 0; e < 4; ++e) { const float z0 = bf_lo(zw[e]) + bg[2 * e], z1 = bf_hi(zw[e]) + bg[2 * e + 1];
              cs[2 * e] = (fminf(z0, 0.f) - log1pf(__expf(-fabsf(z0)))) * (1.f / 16.f); cs[2 * e + 1] = (fminf(z1, 0.f) - log1pf(__expf(-fabsf(z1)))) * (1.f / 16.f); } }
#pragma unroll
        for (int off = 8; off < 64; off <<= 1)
#pragma unroll
            for (int e = 0; e < 8; ++e) { const float v = __shfl_up(cs[e], off); if (lane >= off) cs[e] += v; }
        if (lane >= 56) { *(LAS f32x4*)(lds + GL_WT + (wave * 64 + c8) * 4) = (f32x4){cs[0], cs[1], cs[2], cs[3]}; *(LAS f32x4*)(lds + GL_WT + (wave * 64 + c8 + 4) * 4) = (f32x4){cs[4], cs[5], cs[6], cs[7]}; }
        LDS_WAIT(); __syncthreads();
        {
            float off8[8], tot[8];
#pragma unroll
            for (int e = 0; e < 8; ++e) { off8[e] = 0.f; tot[e] = 0.f; }
#pragma unroll
            for (int w = 0; w < 8; ++w) { const f32x4 a0 = *(const LAS f32x4*)(lds + GL_WT + (w * 64 + c8) * 4), a1 = *(const LAS f32x4*)(lds + GL_WT + (w * 64 + c8 + 4) * 4);
#pragma unroll
                for (int e = 0; e < 4; ++e) { tot[e] += a0[e]; tot[4 + e] += a1[e]; if (w < wave) { off8[e] += a0[e]; off8[4 + e] += a1[e]; } } }
            const unsigned qw[4] = {cq.x, cq.y, cq.z, cq.w}, kw[4] = {ck.x, ck.y, ck.z, ck.w};
            unsigned qo[4], ko[4], so[4];
#pragma unroll
            for (int e = 0; e < 4; ++e) {
                const float b0 = off8[2 * e] + cs[2 * e], b1 = off8[2 * e + 1] + cs[2 * e + 1];
                const float q0 = bf_lo(qw[e]), q1 = bf_hi(qw[e]), k0 = bf_lo(kw[e]), k1 = bf_hi(kw[e]);
                qo[e] = cvtpk_s(q0 * __expf(b0), q1 * __expf(b1));
                ko[e] = cvtpk_s(k0 * __expf(-b0), k1 * __expf(-b1));
                so[e] = cvtpk_s(k0 * __expf(tot[2 * e] - b0), k1 * __expf(tot[2 * e + 1] - b1));
            }
            *(LAS v4u*)(lds + GL_QI + t * GQ_STR + c8 * 2) = (v4u){qo[0], qo[1], qo[2], qo[3]};
            *(LAS v4u*)(lds + GL_KI + t * GQ_STR + c8 * 2) = (v4u){ko[0], ko[1], ko[2], ko[3]};
            *(LAS v4u*)(lds + GL_KS + t * GS_STR + c8 * 2) = (v4u){so[0], so[1], so[2], so[3]};
            *(LAS v4u*)(lds + GL_V + t * GV_STR + c8 * 2) = cv0; *(LAS v4u*)(lds + GL_V + t * GV_STR + 128 + c8 * 2) = cv1;
            if (t == 63) { *(LAS f32x4*)(lds + GL_DEC + c8 * 4) = (f32x4){__expf(tot[0]), __expf(tot[1]), __expf(tot[2]), __expf(tot[3])}; *(LAS f32x4*)(lds + GL_DEC + (c8 + 4) * 4) = (f32x4){__expf(tot[4]), __expf(tot[5]), __expf(tot[6]), __expf(tot[7])}; }
        }
        const v4u pg0 = cg0, pg1 = cg1;
        { const int nn = (n + 1 < SEQ / CHUNK) ? n + 1 : n; GLA_LOADS(nn, cz, cq, ck, cv0, cv1, cg0, cg1); }
        LDS_WAIT(); __syncthreads();
        {
            bf16x8 Qf[4][2], Kf[4][2];
#pragma unroll
            for (int nt = 0; nt < 4; ++nt)
#pragma unroll
                for (int s = 0; s < 2; ++s) {
                    const LAS unsigned char* pq = lds + GL_QI + (16 * nt + fr) * GQ_STR + (32 * s + 4 * fq) * 2; const LAS unsigned char* pk = lds + GL_KI + (16 * nt + fr) * GQ_STR + (32 * s + 4 * fq) * 2;
                    const v2u ql = *(const LAS v2u*)pq, qh = *(const LAS v2u*)(pq + 32), kl = *(const LAS v2u*)pk, kh = *(const LAS v2u*)(pk + 32);
                    Qf[nt][s] = __builtin_bit_cast(bf16x8, (v4u){ql.x, ql.y, qh.x, qh.y}); Kf[nt][s] = __builtin_bit_cast(bf16x8, (v4u){kl.x, kl.y, kh.x, kh.y});
                }
            bf16x8 Vf[2];
#pragma unroll
            for (int s = 0; s < 2; ++s) { const LAS unsigned char* p = lds + GL_V + (32 * s + 4 * fq + trq) * GV_STR + (16 * wave + 4 * trp) * 2;
                const v4i16_t a = ds_tr(p), c = ds_tr(p + 16 * GV_STR); Vf[s] = (bf16x8){a[0], a[1], a[2], a[3], c[0], c[1], c[2], c[3]}; }
            f32x4 Oacc[4];
            const f32x4 zero4 = (f32x4){0.f, 0.f, 0.f, 0.f};
#pragma unroll
            for (int nt = 0; nt < 4; ++nt) {
                f32x4 sc[4];
#pragma unroll
                for (int mt = 0; mt < 4; ++mt) {
                    if (mt > nt) { sc[mt] = zero4; continue; }
                    f32x4 a = zero4;
#pragma unroll
                    for (int s = 0; s < 2; ++s) a = mfma16(Kf[mt][s], Qf[nt][s], a);
                    if (mt == nt) {
#pragma unroll
                        for (int r = 0; r < 4; ++r) if (4 * fq + r > fr) a[r] = 0.f;
                    }
                    sc[mt] = a;
                }
                f32x4 o = zero4;
                o = mfma16(pack8(sc[0], sc[1]), Vf[0], o);
                if (nt >= 2) o = mfma16(pack8(sc[2], sc[3]), Vf[1], o);
                Oacc[nt] = o;
            }
            {
                bf16x8 Sf[2];
#pragma unroll
                for (int s = 0; s < 2; ++s) Sf[s] = pack8(Sacc[2 * s], Sacc[2 * s + 1]);
#pragma unroll
                for (int nt = 0; nt < 4; ++nt)
#pragma unroll
                    for (int s = 0; s < 2; ++s) Oacc[nt] = mfma16(Qf[nt][s], Sf[s], Oacc[nt]);
            }
#pragma unroll
            for (int nt = 0; nt < 4; ++nt)
#pragma unroll
                for (int r = 0; r < 4; ++r) Lo[(16 * nt + 4 * fq + r) * GO_STR + 16 * wave + fr] = Oacc[nt][r];
#pragma unroll
            for (int m = 0; m < 4; ++m) { const f32x4 d = *(const LAS f32x4*)(lds + GL_DEC + (16 * m + 4 * fq) * 4); f32x4 sa = Sacc[m] * d;
#pragma unroll
                for (int s = 0; s < 2; ++s) { const LAS unsigned char* p = lds + GL_KS + (32 * s + 4 * fq + trq) * GS_STR + (16 * m + 4 * trp) * 2;
                    const v4i16_t a = ds_tr(p), c = ds_tr(p + 16 * GS_STR); const bf16x8 Af = (bf16x8){a[0], a[1], a[2], a[3], c[0], c[1], c[2], c[3]};
                    sa = mfma16(Af, Vf[s], sa); }
                Sacc[m] = sa; }
        }
        LDS_WAIT(); __syncthreads();
        {
            float ov[16]; float s = 0.f;
#pragma unroll
            for (int i4 = 0; i4 < 4; ++i4) { const f32x4 o4 = *(const LAS f32x4*)(Lo + t * GO_STR + 16 * cg + 4 * i4);
#pragma unroll
                for (int e = 0; e < 4; ++e) { ov[4 * i4 + e] = o4[e]; s += o4[e] * o4[e]; } }
            s += __shfl_xor(s, 1); s += __shfl_xor(s, 2); s += __shfl_xor(s, 4);
            const float rstd = rsqrtf(s * (1.f / GDV) + EPS);
            const unsigned gw_[8] = {pg0.x, pg0.y, pg0.z, pg0.w, pg1.x, pg1.y, pg1.z, pg1.w};
            unsigned ow[8];
#pragma unroll
            for (int e = 0; e < 8; ++e) ow[e] = cvtpk_s(ov[2 * e] * rstd * gg[2 * e] * pg8::fast_silu(bf_lo(gw_[e])), ov[2 * e + 1] * rstd * gg[2 * e + 1] * pg8::fast_silu(bf_hi(gw_[e])));
            bf16* po = MIX + (rowbase + (size_t)n * CHUNK + t) * D + h * 128 + 16 * cg;
            *(GAS v4u*)po = (v4u){ow[0], ow[1], ow[2], ow[3]}; *(GAS v4u*)(po + 8) = (v4u){ow[4], ow[5], ow[6], ow[7]};
        }
    }
    __syncthreads();
}

struct Args { const float* in[13]; float* out; unsigned char* ws; int ph_lo, ph_hi; };
static_assert(sizeof(Args) == 13 * 8 + 8 + 8 + 8, "Args has no padding");

__global__ void __launch_bounds__(NWAVES * 64, 2) hymba_fwd(Args args) {
    extern __shared__ __attribute__((aligned(16))) unsigned char lds_raw[];
    LAS unsigned char* lds = (LAS unsigned char*)lds_raw;
    volatile LAS unsigned* MISC = (volatile LAS unsigned*)(lds + MISC_OFF);
    const int tid = threadIdx.x, lane = tid & 63, wave = __builtin_amdgcn_readfirstlane(tid >> 6);
    const int G = gridDim.x, bx = blockIdx.x;
    const int vcu = (G % 8 == 0) ? (bx % 8) * (G / 8) + bx / 8 : bx;
    unsigned char* ws = args.ws;
    gu32* ctl = (gu32*)(ws + WS_CTL);
    const float* x = args.in[0]; const float* norm1_g = args.in[1]; const float* w_in = args.in[2]; const float* w_gate_up = args.in[3]; const float* b_gate = args.in[4];
    const float* gla_g = args.in[5]; const float* conv_w = args.in[6]; const float* w_out = args.in[7]; const float* norm2_g = args.in[8];
    const float* w_fg = args.in[9]; const float* w_fu = args.in[10]; const float* w_fd = args.in[11]; const float* normf_g = args.in[12];
    float* out = args.out;
    bf16* WIN = (bf16*)(ws + WS_WIN); bf16* WOUT = (bf16*)(ws + WS_WOUT); bf16* WGU = (bf16*)(ws + WS_WGU); bf16* WDN = (bf16*)(ws + WS_WDN);
    float* SSQ1 = (float*)(ws + WS_SSQ1); float* SSQ2 = (float*)(ws + WS_SSQ2);
    bf16* XN = (bf16*)(ws + WS_XN); bf16* PROJ = (bf16*)(ws + WS_PROJ); bf16* HID = (bf16*)(ws + WS_PROJ); bf16* MIX = (bf16*)(ws + WS_MIX);

    for (int u = tid; u < (LDS_BYTES - LDSCTL_OFF) / 4; u += NWAVES * 64) ((LAS unsigned*)(lds + LDSCTL_OFF))[u] = 0u;
    __syncthreads();
    XcdBarrier bar; bar.bar = (unsigned*)(ctl + CW_BAR); bar.x = 0; bar.st = nullptr;
    if (N_LAUNCHES == 1) bar = xcd_barrier_post((unsigned*)(ctl + CW_BAR), MISC + 8);
#define GRID_BAR() do { if (N_LAUNCHES == 1) xcd_barrier(bar); } while (0)
    const int lo = args.ph_lo, hi = args.ph_hi;
#define IN(k) (lo <= (k) && (k) < hi)
#define BOTH(k) (IN(k) && IN((k) + 1))
    const int gw = vcu * NWAVES + wave, NGW = G * NWAVES;

    if (IN(0)) {
        LAS float* scr = (LAS float*)(lds + RING_OFF + wave * 16384);
        constexpr int I_IN1 = 16 * 48, I_IN2 = 16 * 48, I_GATE = 16 * 32, I_OUT = 16 * 32, I_FG = 16 * 88, I_FU = 16 * 88, I_FD = 44 * 32;
        constexpr int NITEMS = I_IN1 + I_IN2 + I_GATE + I_OUT + I_FG + I_FU + I_FD;
        for (int it = gw; it < NITEMS; it += NGW) {
            int r = it;
            if (r < I_IN1) { const int kb = r / 48, nb = r % 48; p0_transpose_item(w_in, IN_COLS, D, WIN, 0, kb, nb, nullptr, nb < 8 ? 0.125f : 1.0f, scr, lane); continue; } r -= I_IN1;
            if (r < I_IN2) { const int kb = r / 48, nb = r % 48; p0_transpose_item(w_in + SRC_CB, IN_COLS, D, WIN, PC_CB, kb, nb, nullptr, 1.0f, scr, lane); continue; } r -= I_IN2;
            if (r < I_GATE) { p0_gate_item(w_in, w_gate_up, WIN, r / 32, r % 32, lane); continue; } r -= I_GATE;
            if (r < I_OUT) { p0_transpose_item(w_out, D, D, WOUT, 0, r / 32, r % 32, nullptr, 1.0f, scr, lane); continue; } r -= I_OUT;
            if (r < I_FG) { const int kb = r / 88, nb = r % 88, n0 = 32 * nb; p0_transpose_item(w_fg, FF, D, WGU, 256 * (n0 / 128) + (n0 % 128) - n0, kb, nb, norm2_g, 1.0f, scr, lane); continue; } r -= I_FG;
            if (r < I_FU) { const int kb = r / 88, nb = r % 88, n0 = 32 * nb; p0_transpose_item(w_fu, FF, D, WGU, 256 * (n0 / 128) + 128 + (n0 % 128) - n0, kb, nb, norm2_g, 1.0f, scr, lane); continue; } r -= I_FU;
            p0_transpose_item(w_fd, D, FF, WDN, 0, r / 32, r % 32, nullptr, 1.0f, scr, lane);
        }
        for (int m = gw; m < M; m += NGW) rms_row_to_bf16(x + (size_t)m * D, norm1_g, XN + (size_t)m * D, lane);
        if (BOTH(0)) GRID_BAR();
    }

    if (IN(1)) {
        pg8::Gemm g{XN, WIN, M, NP, D}; pg8::StaticOrder S; S.init(M, NP, G, bx);
        pg8::EpiStoreBf16 E{PROJ, NP};
        pg8::gemm_phase<pg8::EpiStoreBf16, pg8::StaticOrder, PG8_ALIGN, PG8_SP2>(lds + RING_OFF, g, S, E);
        if (BOTH(1)) GRID_BAR();
    }

    if (IN(2)) {
        const bool do_gla = (G <= 64) || (bx < 64), do_conv = (G <= 64) || (bx >= 64);
        if (do_gla) for (int unit = bx; unit < BATCH * GH; unit += G) gla_unit(lds + RING_OFF, PROJ, MIX, b_gate, gla_g, unit >> 2, unit & 3, tid, lane, wave);
        if (do_conv) {
            const int ncw = ((G <= 64) ? G : G - 64) * NWAVES, cw = ((G <= 64) ? bx : bx - 64) * NWAVES + wave;
            const int c0 = lane * 8;
            float w0[8], w1[8], w2[8];
#pragma unroll
            for (int e = 0; e < 8; ++e) { w0[e] = conv_w[c0 + e]; w1[e] = conv_w[CONVW + c0 + e]; w2[e] = conv_w[2 * CONVW + c0 + e]; }
            for (int item = cw; item < M / 8; item += ncw) {
                const int m0 = item * 8, s0 = m0 % SEQ;
                float um2[8], um1[8];
#pragma unroll
                for (int e = 0; e < 8; ++e) { um2[e] = 0.f; um1[e] = 0.f; }
                if (s0 > 0) {
#pragma unroll
                    for (int back = 2; back >= 1; --back) { const bf16* pr = PROJ + (size_t)(m0 - back) * NP;
                        const v4u cc = *(const GAS v4u*)(pr + PC_CC + c0), ch = *(const GAS v4u*)(pr + PC_CH + c0);
                        const unsigned ca[4] = {cc.x, cc.y, cc.z, cc.w}, ha[4] = {ch.x, ch.y, ch.z, ch.w};
#pragma unroll
                        for (int e = 0; e < 4; ++e) { const float u0 = bf_lo(ca[e]) * bf_lo(ha[e]), u1 = bf_hi(ca[e]) * bf_hi(ha[e]);
                            if (back == 2) { um2[2 * e] = u0; um2[2 * e + 1] = u1; } else { um1[2 * e] = u0; um1[2 * e + 1] = u1; } } }
                }
#pragma unroll
                for (int rr = 0; rr < 8; ++rr) { const bf16* pr = PROJ + (size_t)(m0 + rr) * NP;
                    const v4u cb = *(const GAS v4u*)(pr + PC_CB + c0), cc = *(const GAS v4u*)(pr + PC_CC + c0), ch = *(const GAS v4u*)(pr + PC_CH + c0);
                    const unsigned ba[4] = {cb.x, cb.y, cb.z, cb.w}, ca[4] = {cc.x, cc.y, cc.z, cc.w}, ha[4] = {ch.x, ch.y, ch.z, ch.w};
                    unsigned ow[4];
#pragma unroll
                    for (int e = 0; e < 4; ++e) { const float u0 = bf_lo(ca[e]) * bf_lo(ha[e]), u1 = bf_hi(ca[e]) * bf_hi(ha[e]);
                        const float y0 = w0[2 * e] * um2[2 * e] + w1[2 * e] * um1[2 * e] + w2[2 * e] * u0, y1 = w0[2 * e + 1] * um2[2 * e + 1] + w1[2 * e + 1] * um1[2 * e + 1] + w2[2 * e + 1] * u1;
                        ow[e] = pk2(bf_lo(ba[e]) * y0, bf_hi(ba[e]) * y1);
                        um2[2 * e] = um1[2 * e]; um2[2 * e + 1] = um1[2 * e + 1]; um1[2 * e] = u0; um1[2 * e + 1] = u1; }
                    *(GAS v4u*)(MIX + (size_t)(m0 + rr) * D + CONVW + c0) = (v4u){ow[0], ow[1], ow[2], ow[3]}; }
            }
        }
        if (BOTH(2)) GRID_BAR();
    }

    if (IN(3)) {
        pg8::Gemm g{MIX, WOUT, M, D, D}; pg8::StaticOrder S; S.init(M, D, G, bx);
        pg8::EpiResid<true> E{x, out, XN, SSQ1, D};
        pg8::gemm_phase<pg8::EpiResid<true>, pg8::StaticOrder, PG8_ALIGN, PG8_SP2>(lds + RING_OFF, g, S, E);
        if (BOTH(3)) GRID_BAR();
    }

    if (IN(4)) {
        pg8::Gemm g{XN, WGU, M, NGU, D}; pg8::StaticOrder S; S.init(M, NGU, G, bx);
        pg8::EpiSwiglu E{HID, FF, SSQ1, 1.f / D, EPS};
        pg8::gemm_phase<pg8::EpiSwiglu, pg8::StaticOrder, PG8_ALIGN, PG8_SP2>(lds + RING_OFF, g, S, E);
        if (BOTH(4)) GRID_BAR();
    }

    if (IN(5)) {
        pg8::Gemm g{HID, WDN, M, D, FF}; pg8::StaticOrder S; S.init(M, D, G, bx);
        pg8::EpiResid<false> E{out, out, nullptr, SSQ2, D};
        pg8::gemm_phase<pg8::EpiResid<false>, pg8::StaticOrder, PG8_ALIGN, PG8_SP2>(lds + RING_OFF, g, S, E);
        if (BOTH(5)) GRID_BAR();
    }

    if (IN(6)) {
        for (int m = gw; m < M; m += NGW) {
            const GAS f32x4* p = (const GAS f32x4*)(SSQ2 + (size_t)m * 16); const f32x4 a = p[0], b = p[1], c = p[2], d = p[3];
            const f32x4 t = (a + b) + (c + d); const float rstd = rsqrtf(((t[0] + t[1]) + (t[2] + t[3])) * (1.f / D) + EPS);
            GAS f32x4* xr = (GAS f32x4*)(out + (size_t)m * D) + lane; const GAS f32x4* gr = (const GAS f32x4*)normf_g + lane;
#pragma unroll
            for (int j = 0; j < 4; ++j) { const f32x4 v = xr[64 * j], gg = gr[64 * j]; xr[64 * j] = v * rstd * gg; }
        }
    }
#undef IN
#undef BOTH
}

extern "C" void kernel_launch(void* const* d_in, const int* in_sizes, int n_in, void* d_out, int out_size, void* d_ws, size_t ws_size, hipStream_t stream) {
    static int grid = 0;
    if (grid == 0) {
        if (n_in != 13 || in_sizes[0] != M * D || out_size != M * D || ws_size < WS_END) { fprintf(stderr, "kernel_launch: unexpected shapes (n_in %d, in0 %d, out %d, ws %zu); nothing launched\n", n_in, n_in > 0 ? in_sizes[0] : -1, out_size, ws_size); grid = -1; return; }
        int dev = 0, cus = 0, per_cu = 0;
        if (hipGetDevice(&dev) != hipSuccess || hipDeviceGetAttribute(&cus, hipDeviceAttributeMultiprocessorCount, dev) != hipSuccess) { fprintf(stderr, "kernel_launch: device query failed\n"); grid = -1; return; }
        if (hipFuncSetAttribute((const void*)hymba_fwd, hipFuncAttributeMaxDynamicSharedMemorySize, LDS_BYTES) != hipSuccess) { fprintf(stderr, "kernel_launch: hipFuncSetAttribute failed\n"); grid = -1; return; }
        if (hipOccupancyMaxActiveBlocksPerMultiprocessor(&per_cu, (const void*)hymba_fwd, NWAVES * 64, LDS_BYTES) != hipSuccess || per_cu < 1)
            fprintf(stderr, "kernel_launch: note: occupancy query reports %d workgroups per CU\n", per_cu);
        (void)hipGetLastError();
        grid = cus;
    }
    if (grid < 0) return;
    if (hipMemsetAsync((char*)d_ws + WS_CTL, 0, CTL_ZERO_BYTES, stream) != hipSuccess) { fprintf(stderr, "kernel_launch: hipMemsetAsync failed\n"); return; }
    Args a{};
    for (int i = 0; i < 13; ++i) a.in[i] = (const float*)d_in[i];
    a.out = (float*)d_out; a.ws = (unsigned char*)d_ws;
    for (int li = 0; li < N_LAUNCHES; ++li) {
        a.ph_lo = (N_LAUNCHES == 1) ? 0 : li; a.ph_hi = (N_LAUNCHES == 1) ? N_PHASES : li + 1;
        hipLaunchKernelGGL(hymba_fwd, dim3(grid), dim3(NWAVES * 64), LDS_BYTES, stream, a);
        const hipError_t le = hipPeekAtLastError();
        if (le != hipSuccess) { fprintf(stderr, "kernel_launch: launch %d failed: %s\n", li, hipGetErrorName(le)); break; }
    }
}
```

```cpp
#include <hip/hip_runtime.h>
#include <cstdio>
#include <cstdint>
namespace pg8 {
#define PG8_LAS __attribute__((address_space(3)))
typedef unsigned short bf16_t;
typedef short bf16x8 __attribute__((ext_vector_type(8)));
typedef float f32x4 __attribute__((ext_vector_type(4)));
typedef unsigned u32x4 __attribute__((ext_vector_type(4)));
constexpr int BM = 256, BK = 64, HALF = 128, HTB = HALF * BK * 2  , STAGE_BYTES = 8 * HTB, NXCD = 8, WGM = 8;

__host__ __device__ __forceinline__ int lds_byte(int r, int c) { const int st = (r >> 4) * 2 + (c >> 5), rr = r & 15, cc = c & 31, ob = rr * 64 + cc * 2; return st * 1024 + (ob ^ (((ob >> 9) & 1) << 5)); }
__host__ __device__ __forceinline__ void stage_rc(int b, int& R, int& C) { const int st = b / 1024, sb = b % 1024, swz = sb ^ (((sb >> 9) & 1) << 5); R = (st >> 1) * 16 + swz / 64; C = (st & 1) * 32 + (swz % 64) / 2; }
__host__ __device__ __forceinline__ int perm32(int rho) { const int n = rho >> 4, i = rho & 15; return 8 * (i >> 2) + 4 * n + (i & 3); }

struct Unit { int pm, pn; };
struct Gemm { const bf16_t* A; const bf16_t* Bt; int M, N, K; };

struct StaticOrder {
    int nM, nN, nwg, G, c;
    __host__ __device__ void init(int M, int N, int G_, int c_) { nM = M / BM; nN = N / BM; nwg = nM * nN; G = G_; c = c_; }
    __host__ __device__ bool next(int i, Unit& u) const {
        const long L = (long)i * G + c; if (L >= nwg) return false;
        int wgid = (int)L; { const int q = nwg / NXCD, r = nwg % NXCD, xcd = wgid % NXCD, off = wgid / NXCD; wgid = (xcd < r ? xcd * (q + 1) : r * (q + 1) + (xcd - r) * q) + off; }
        const int nig = WGM * nN, gid = wgid / nig, fm = gid * WGM, gsz = (nM - fm) < WGM ? (nM - fm) : WGM;
        u.pm = fm + ((wgid % nig) % gsz); u.pn = (wgid % nig) / gsz; return true;
    }
    __device__ __forceinline__ void a_ready(const Unit&) const {}
    __device__ __forceinline__ void done(const Unit&) const {}
};

__device__ __forceinline__ unsigned cvt_pk_bf16(float lo, float hi) { unsigned r; asm volatile("v_cvt_pk_bf16_f32 %0, %1, %2" : "=v"(r) : "v"(lo), "v"(hi)); return r; }

__device__ __forceinline__ float fast_silu(float g) { return g * __builtin_amdgcn_rcpf(1.0f + __builtin_amdgcn_exp2f(-1.44269504089f * g)); }

struct EpiStoreBf16 {
    static constexpr bool PERM = true, AFTER_DRAIN = false;
    bf16_t* O; int ldc;
    __device__ __forceinline__ void operator()(const f32x4 (&acc)[2][2][4][2], const Unit& u, int wr, int wc, int fr, int fq) const {
        const int row0 = u.pm * BM + wr * 64 + fr, col0 = u.pn * BM + wc * 32 + 8 * fq;
#pragma unroll
        for (int ai = 0; ai < 2; ++ai)
#pragma unroll
            for (int m = 0; m < 4; ++m) { bf16_t* rowp = O + (size_t)(row0 + ai * HALF + m * 16) * ldc + col0;
#pragma unroll
                for (int bj = 0; bj < 2; ++bj) { const f32x4 v0 = acc[ai][bj][m][0], v1 = acc[ai][bj][m][1];
                    u32x4 w; w.x = cvt_pk_bf16(v0[0], v0[1]); w.y = cvt_pk_bf16(v0[2], v0[3]); w.z = cvt_pk_bf16(v1[0], v1[1]); w.w = cvt_pk_bf16(v1[2], v1[3]);
                    *(u32x4*)(rowp + bj * HALF) = w; } }
    }
};
template <bool BASE_BF16, bool OUT_F32, bool OUT_BF16> struct EpiResid {
    static constexpr bool PERM = true, AFTER_DRAIN = false;
    const float* basef; const bf16_t* baseb; float* out; bf16_t* xb; float* ssq; int ldc;
    __device__ __forceinline__ void operator()(const f32x4 (&acc)[2][2][4][2], const Unit& u, int wr, int wc, int fr, int fq) const {
        const int row0 = u.pm * BM + wr * 64 + fr, col0 = u.pn * BM + wc * 32 + 8 * fq;
#pragma unroll
        for (int ai = 0; ai < 2; ++ai)
#pragma unroll
            for (int m = 0; m < 4; ++m) { const int row = row0 + ai * HALF + m * 16; const size_t off = (size_t)row * ldc + col0; float s = 0.f;
#pragma unroll
                for (int bj = 0; bj < 2; ++bj) {
                    f32x4 b0, b1;
                    if (BASE_BF16) { const u32x4 w = *(const u32x4*)(baseb + off + bj * HALF);
                        b0 = (f32x4){__builtin_bit_cast(float, w.x << 16), __builtin_bit_cast(float, w.x & 0xffff0000u), __builtin_bit_cast(float, w.y << 16), __builtin_bit_cast(float, w.y & 0xffff0000u)};
                        b1 = (f32x4){__builtin_bit_cast(float, w.z << 16), __builtin_bit_cast(float, w.z & 0xffff0000u), __builtin_bit_cast(float, w.w << 16), __builtin_bit_cast(float, w.w & 0xffff0000u)}; }
                    else { b0 = *(const f32x4*)(basef + off + bj * HALF); b1 = *(const f32x4*)(basef + off + bj * HALF + 4); }
                    const f32x4 v0 = acc[ai][bj][m][0] + b0, v1 = acc[ai][bj][m][1] + b1;
                    if (OUT_F32) { *(f32x4*)(out + off + bj * HALF) = v0; *(f32x4*)(out + off + bj * HALF + 4) = v1; }
                    s += (v0[0] * v0[0] + v0[1] * v0[1]) + (v0[2] * v0[2] + v0[3] * v0[3]) + (v1[0] * v1[0] + v1[1] * v1[1]) + (v1[2] * v1[2] + v1[3] * v1[3]);
                    if (OUT_BF16) { u32x4 w; w.x = cvt_pk_bf16(v0[0], v0[1]); w.y = cvt_pk_bf16(v0[2], v0[3]); w.z = cvt_pk_bf16(v1[0], v1[1]); w.w = cvt_pk_bf16(v1[2], v1[3]);
                        *(u32x4*)(xb + off + bj * HALF) = w; } }
                s += __shfl_xor(s, 16); s += __shfl_xor(s, 32);
                if (fq == 0) ssq[(size_t)row * 16 + u.pn * 4 + wc] = s; }
    }
};
struct EpiSwiglu {
    static constexpr bool PERM = true, AFTER_DRAIN = false;
    bf16_t* H; int ldh; const float* ssq; float inv_n, eps;
    __device__ __forceinline__ void operator()(const f32x4 (&acc)[2][2][4][2], const Unit& u, int wr, int wc, int fr, int fq) const {
        const int row0 = u.pm * BM + wr * 64 + fr, col0 = u.pn * HALF + wc * 32 + 8 * fq;
#pragma unroll
        for (int ai = 0; ai < 2; ++ai)
#pragma unroll
            for (int m = 0; m < 4; ++m) { const int row = row0 + ai * HALF + m * 16;
                const f32x4* p = (const f32x4*)(ssq + (size_t)row * 16); const f32x4 a = p[0], b = p[1], c = p[2], d = p[3];
                const f32x4 t = (a + b) + (c + d); const float rstd = rsqrtf(((t[0] + t[1]) + (t[2] + t[3])) * inv_n + eps);
                float hv[8];
#pragma unroll
                for (int n = 0; n < 2; ++n)
#pragma unroll
                    for (int e = 0; e < 4; ++e) { const float g = acc[ai][0][m][n][e] * rstd, uu = acc[ai][1][m][n][e] * rstd; hv[n * 4 + e] = fast_silu(g) * uu; }
                u32x4 w; w.x = cvt_pk_bf16(hv[0], hv[1]); w.y = cvt_pk_bf16(hv[2], hv[3]); w.z = cvt_pk_bf16(hv[4], hv[5]); w.w = cvt_pk_bf16(hv[6], hv[7]);
                *(u32x4*)(H + (size_t)row * ldh + col0) = w; }
    }
};

template <class Epi, class Sched, bool ALIGN_EPI = false, bool SP2 = false>
__device__ __forceinline__ void gemm_phase(PG8_LAS unsigned char* lds, const Gemm g, const Sched& S, const Epi& E) {
    const int tid = threadIdx.x, wid = __builtin_amdgcn_readfirstlane(tid >> 6), lane = tid & 63, wr = wid >> 2, wc = wid & 3, fr = lane & 15, fq = lane >> 4;
    const int K = g.K, nt = K / BK;
    unsigned voffA[2], voffB[2];
#pragma unroll
    for (int i = 0; i < 2; ++i) { int R, C; stage_rc(tid * 16 + i * 8192, R, C); const int Rb = Epi::PERM ? ((R & ~31) + perm32(R & 31)) : R;
        voffA[i] = (unsigned)(R * K + C) * 2u; voffB[i] = (unsigned)(Rb * K + C) * 2u; }
    const size_t kstep = (size_t)(BK * 2);
    const size_t hstep = (size_t)HALF * K * 2;
    const size_t tstep = 2 * hstep;
    const unsigned ldsw = (unsigned)wid * 1024u;
    const int aoff = lds_byte(wr * 64 + fr, fq * 8), boff = lds_byte(wc * 32 + fr, fq * 8);
#define PG8_SA(b, h) (((b) * 2 + (h)) * HTB)
#define PG8_SB(b, h) ((4 + (b) * 2 + (h)) * HTB)
#define PG8_STAGE(bufoff, gbase, voff) do { _Pragma("unroll") for (int _i = 0; _i < 2; ++_i) \
        __builtin_amdgcn_global_load_lds((const unsigned*)((const char*)(gbase) + (voff)[_i]), (PG8_LAS unsigned*)(lds + (bufoff) + ldsw + _i * 8192), 16, 0, 0); } while (0)
#define PG8_LDA(dst, b, h) do { _Pragma("unroll") for (int m = 0; m < 4; ++m) _Pragma("unroll") for (int k = 0; k < 2; ++k) dst[m][k] = *(const PG8_LAS bf16x8*)(lds + PG8_SA(b, h) + aoff + m * 2048 + k * 1024); } while (0)
#define PG8_LDB(dst, b, h) do { _Pragma("unroll") for (int n = 0; n < 2; ++n) _Pragma("unroll") for (int k = 0; k < 2; ++k) dst[n][k] = *(const PG8_LAS bf16x8*)(lds + PG8_SB(b, h) + boff + n * 2048 + k * 1024); } while (0)
#define PG8_MMA(ai, bj, At, Bt) do { __builtin_amdgcn_s_setprio(1); _Pragma("unroll") for (int m = 0; m < 4; ++m) _Pragma("unroll") for (int n = 0; n < 2; ++n) _Pragma("unroll") for (int k = 0; k < 2; ++k) \
        acc[ai][bj][m][n] = __builtin_amdgcn_mfma_f32_16x16x32_bf16(Bt[n][k], At[m][k], acc[ai][bj][m][n], 0, 0, 0); __builtin_amdgcn_s_setprio(0); } while (0)
#define PG8_WAIT_V(n) asm volatile("s_waitcnt vmcnt(" #n ")" ::: "memory")
#define PG8_WAIT_L(n) asm volatile("s_waitcnt lgkmcnt(" #n ")" ::: "memory")
#define PG8_BAR __builtin_amdgcn_s_barrier()
#define PG8_SCHED __builtin_amdgcn_sched_barrier(0)
    Unit cur, nxt; int ui = 0;
    if (!S.next(0, cur)) return;
    f32x4 acc[2][2][4][2];
#pragma unroll
    for (int a = 0; a < 2; ++a)
#pragma unroll
        for (int b = 0; b < 2; ++b)
#pragma unroll
            for (int m = 0; m < 4; ++m)
#pragma unroll
                for (int n = 0; n < 2; ++n) acc[a][b][m][n] = (f32x4){0.f, 0.f, 0.f, 0.f};
    bf16x8 At[4][2], B0[2][2], B1[2][2];
    const char* cA = (const char*)g.A + (size_t)cur.pm * tstep; const char* cB = (const char*)g.Bt + (size_t)cur.pn * tstep;
    S.a_ready(cur);
    if constexpr (SP2) {
        PG8_STAGE(PG8_SB(0, 0), cB, voffB); PG8_STAGE(PG8_SB(0, 1), cB + hstep, voffB); PG8_STAGE(PG8_SA(0, 0), cA, voffA); PG8_STAGE(PG8_SA(0, 1), cA + hstep, voffA);
        if (wr == 1) PG8_BAR;
        PG8_WAIT_V(2); PG8_BAR;
        PG8_STAGE(PG8_SB(1, 0), cB + kstep, voffB); PG8_STAGE(PG8_SA(1, 0), cA + kstep, voffA); PG8_STAGE(PG8_SB(1, 1), cB + hstep + kstep, voffB);
        PG8_WAIT_V(6); PG8_BAR;
    } else {
        PG8_STAGE(PG8_SB(0, 0), cB, voffB); PG8_STAGE(PG8_SA(0, 0), cA, voffA); PG8_STAGE(PG8_SB(0, 1), cB + hstep, voffB); PG8_STAGE(PG8_SA(0, 1), cA + hstep, voffA);
        if (wr == 1) PG8_BAR;
        PG8_WAIT_V(4); PG8_BAR;
        PG8_STAGE(PG8_SB(1, 0), cB + kstep, voffB); PG8_STAGE(PG8_SA(1, 0), cA + kstep, voffA); PG8_STAGE(PG8_SB(1, 1), cB + hstep + kstep, voffB);
        PG8_WAIT_V(6); PG8_BAR;
    }
    for (;;) {
        const bool has_next = S.next(ui + 1, nxt);
        const char* nA = has_next ? (const char*)g.A + (size_t)nxt.pm * tstep : cA; const char* nB = has_next ? (const char*)g.Bt + (size_t)nxt.pn * tstep : cB;
        for (int t = 0; t < nt; t += 2) {
            const bool last = (t == nt - 2);
            const char* a1 = cA + (size_t)(t + 1) * kstep;
            const char* a2 = last ? nA : cA + (size_t)(t + 2) * kstep; const char* b2 = last ? nB : cB + (size_t)(t + 2) * kstep;
            const char* a3 = a2 + kstep; const char* b3 = b2 + kstep;
            if (last && has_next) S.a_ready(nxt);
            if constexpr (SP2) {
            PG8_LDB(B0, 0, 0); PG8_LDB(B1, 0, 1); PG8_SCHED; PG8_LDA(At, 0, 0); PG8_STAGE(PG8_SA(1, 1), a1 + hstep, voffA);
            PG8_WAIT_V(8); PG8_WAIT_L(0); PG8_BAR; PG8_MMA(0, 0, At, B0); PG8_MMA(0, 1, At, B1); PG8_BAR; PG8_SCHED;
            PG8_LDA(At, 0, 1); PG8_STAGE(PG8_SB(0, 0), b2, voffB); PG8_STAGE(PG8_SB(0, 1), b2 + hstep, voffB); PG8_STAGE(PG8_SA(0, 0), a2, voffA);
            PG8_WAIT_V(8); PG8_WAIT_L(0); PG8_BAR; PG8_MMA(1, 0, At, B0); PG8_MMA(1, 1, At, B1); PG8_BAR; PG8_SCHED;
            PG8_LDB(B0, 1, 0); PG8_LDB(B1, 1, 1); PG8_SCHED; PG8_LDA(At, 1, 0); PG8_STAGE(PG8_SA(0, 1), a2 + hstep, voffA);
            PG8_WAIT_V(8); PG8_WAIT_L(0); PG8_BAR; PG8_MMA(0, 0, At, B0); PG8_MMA(0, 1, At, B1); PG8_BAR; PG8_SCHED;
            PG8_LDA(At, 1, 1); PG8_STAGE(PG8_SB(1, 0), b3, voffB); PG8_STAGE(PG8_SB(1, 1), b3 + hstep, voffB); PG8_STAGE(PG8_SA(1, 0), a3, voffA);
            PG8_WAIT_V(8); PG8_WAIT_L(0); PG8_BAR; PG8_MMA(1, 0, At, B0); PG8_MMA(1, 1, At, B1); PG8_BAR; PG8_SCHED;
            } else {
            PG8_LDB(B0, 0, 0); PG8_SCHED; PG8_LDA(At, 0, 0); PG8_STAGE(PG8_SA(1, 1), a1 + hstep, voffA);
            PG8_WAIT_L(8); PG8_BAR; PG8_WAIT_L(0); PG8_MMA(0, 0, At, B0); PG8_BAR; PG8_SCHED;
            PG8_LDB(B1, 0, 1); PG8_STAGE(PG8_SB(0, 0), b2, voffB);
            PG8_BAR; PG8_WAIT_L(0); PG8_MMA(0, 1, At, B1); PG8_BAR;
            PG8_LDA(At, 0, 1); PG8_STAGE(PG8_SA(0, 0), a2, voffA);
            PG8_BAR; PG8_WAIT_L(0); PG8_MMA(1, 0, At, B0); PG8_BAR; PG8_SCHED;
            PG8_STAGE(PG8_SB(0, 1), b2 + hstep, voffB);
            PG8_WAIT_V(6); PG8_BAR; PG8_MMA(1, 1, At, B1); PG8_BAR;
            PG8_LDB(B0, 1, 0); PG8_SCHED; PG8_LDA(At, 1, 0); PG8_STAGE(PG8_SA(0, 1), a2 + hstep, voffA);
            PG8_WAIT_L(8); PG8_BAR; PG8_WAIT_L(0); PG8_MMA(0, 0, At, B0); PG8_BAR; PG8_SCHED;
            PG8_LDB(B1, 1, 1); PG8_STAGE(PG8_SB(1, 0), b3, voffB);
            PG8_BAR; PG8_WAIT_L(0); PG8_MMA(0, 1, At, B1); PG8_BAR;
            PG8_LDA(At, 1, 1); PG8_STAGE(PG8_SA(1, 0), a3, voffA);
            PG8_BAR; PG8_WAIT_L(0); PG8_MMA(1, 0, At, B0); PG8_BAR; PG8_SCHED;
            PG8_STAGE(PG8_SB(1, 1), b3 + hstep, voffB);
            PG8_WAIT_V(6); PG8_BAR; PG8_MMA(1, 1, At, B1); PG8_BAR;
            }
        }
        if constexpr (ALIGN_EPI) { if (wr == 0) PG8_BAR; }
        if constexpr (!Epi::AFTER_DRAIN) { E(acc, cur, wr, wc, fr, fq); S.done(cur); }
        if (!has_next) break;
#pragma unroll
        for (int a = 0; a < 2; ++a)
#pragma unroll
            for (int b = 0; b < 2; ++b)
#pragma unroll
                for (int m = 0; m < 4; ++m)
#pragma unroll
                    for (int n = 0; n < 2; ++n) acc[a][b][m][n] = (f32x4){0.f, 0.f, 0.f, 0.f};
        cur = nxt; cA = nA; cB = nB; ++ui;
        if constexpr (ALIGN_EPI) { if (wr == 1) PG8_BAR; }
    }
    PG8_WAIT_V(0);
    if constexpr (!ALIGN_EPI) { if (wr == 0) PG8_BAR; }
    PG8_BAR;
    if constexpr (Epi::AFTER_DRAIN) { E.fused(acc, cur, wr, wc, fr, fq, lds, wid, lane); S.done(cur); }
#undef PG8_SA
#undef PG8_SB
#undef PG8_STAGE
#undef PG8_LDA
#undef PG8_LDB
#undef PG8_MMA
#undef PG8_WAIT_V
#undef PG8_WAIT_L
#undef PG8_BAR
#undef PG8_SCHED
}
}

#ifndef PG8_SP2
#define PG8_SP2 true
#endif
#ifndef PG8_ALIGN
#define PG8_ALIGN true
#endif

#define GAS __attribute__((address_space(1)))
#define LAS __attribute__((address_space(3)))
typedef unsigned short bf16;
typedef unsigned v4u __attribute__((ext_vector_type(4)));
typedef float f32x4 __attribute__((ext_vector_type(4)));
typedef short bf16x8 __attribute__((ext_vector_type(8)));
typedef GAS unsigned gu32;
typedef GAS unsigned long long gu64;
#define RLX_AGENT __ATOMIC_RELAXED, __HIP_MEMORY_SCOPE_AGENT
#define LDS_WAIT() asm volatile("s_waitcnt lgkmcnt(0)" ::: "memory")
#define VM_WAIT() asm volatile("s_waitcnt vmcnt(0)" ::: "memory")
__device__ __forceinline__ unsigned long long rt() { return __builtin_amdgcn_s_memrealtime(); }
__device__ __forceinline__ unsigned f2bf(float f) { unsigned u = __builtin_bit_cast(unsigned, f); return (u + 0x7fffu + ((u >> 16) & 1u)) >> 16; }
__device__ __forceinline__ unsigned pk2(float lo, float hi) { return f2bf(lo) | (f2bf(hi) << 16); }

#define XB_TMO      128
#define XB_XCNT(j)  (256  + 64 * (j))
#define XB_XSUB(j)  (1280 + 64 * (j))
#define XB_XGEN(j)  (2304 + 64 * (j))
#define XB_TOP      3328
#define XB_TOPGEN   3392
#define XCD_BAR_WORDS 3456
#define XB_SPIN_CAP (1u << 18)

__device__ __forceinline__ unsigned xb_ld(unsigned* p)              { return __hip_atomic_load(p, __ATOMIC_RELAXED, __HIP_MEMORY_SCOPE_AGENT); }
__device__ __forceinline__ unsigned xb_add(unsigned* p, unsigned v) { return __hip_atomic_fetch_add(p, v, __ATOMIC_RELAXED, __HIP_MEMORY_SCOPE_AGENT); }
__device__ __forceinline__ unsigned xb_xcc_id() { return (unsigned)__builtin_amdgcn_s_getreg((3 << 11) | 20) & 0xFu; }
#define XB_SPIN(cond, bar) do { unsigned _sp = 0; while (cond) { __builtin_amdgcn_s_sleep(1); \
    if ((++_sp & 255u) == 0u) { if (xb_ld(&(bar)[XB_TMO])) break; if (_sp > XB_SPIN_CAP) { atomicAdd(&(bar)[XB_TMO], 1u); break; } } } } while (0)

struct XcdBarrier {
    unsigned* bar; unsigned x;
    volatile LAS unsigned* st;
};

__device__ __forceinline__ XcdBarrier xcd_barrier_post(unsigned* bar, volatile LAS unsigned* st) {
    XcdBarrier b; b.bar = bar; b.x = xb_xcc_id(); b.st = st;
    if (threadIdx.x == 0) (void)xb_add(&bar[XB_XCNT(b.x)], 1u);
    return b;
}
__device__ __forceinline__ void xcd_barrier_complete(unsigned* bar, unsigned x, unsigned& nloc, unsigned& nx) {
    const unsigned G = gridDim.x * gridDim.y * gridDim.z;
    unsigned sum, cnt, mine, sp = 0u;
    for (;;) {
        sum = 0u; cnt = 0u; mine = 0u;
#pragma unroll
        for (unsigned j = 0; j < 16; ++j) { const unsigned c = xb_ld(&bar[XB_XCNT(j)]); sum += c; cnt += (c > 0u) ? 1u : 0u; mine = (j == x) ? c : mine; }
        if (sum == G) break;
        __builtin_amdgcn_s_sleep(1);
        if ((++sp & 255u) == 0u) { if (xb_ld(&bar[XB_TMO])) break; if (sp > XB_SPIN_CAP) { atomicAdd(&bar[XB_TMO], 1u); break; } }
    }
    nloc = mine > 0u ? mine : 1u; nx = cnt > 0u ? cnt : 1u;
}

__device__ __forceinline__ void xcd_barrier(const XcdBarrier& b) {
    asm volatile("s_waitcnt vmcnt(0)" ::: "memory");
    __syncthreads();
    if (threadIdx.x == 0) {
        unsigned* bar = b.bar;
        __builtin_amdgcn_s_waitcnt(0);
        unsigned nloc = b.st[0], nx = b.st[1];
        if (nloc == 0u) { xcd_barrier_complete(bar, b.x, nloc, nx); b.st[0] = nloc; b.st[1] = nx; }
        const unsigned old = xb_add(&bar[XB_XSUB(b.x)], 1u);
        const unsigned gen = old / nloc;
        if (old + 1u == (gen + 1u) * nloc) {
            __builtin_amdgcn_fence(__ATOMIC_RELEASE, "agent");
            asm volatile("s_waitcnt vmcnt(0)" ::: "memory");
            const unsigned og = xb_add(&bar[XB_TOP], 1u);
            const unsigned tg = og / nx;
            if (og + 1u == (tg + 1u) * nx) xb_add(&bar[XB_TOPGEN], 1u);
            else XB_SPIN(xb_ld(&bar[XB_TOPGEN]) == tg, bar);
            __builtin_amdgcn_fence(__ATOMIC_ACQUIRE, "agent");
            xb_add(&bar[XB_XGEN(b.x)], 1u);
            asm volatile("s_waitcnt vmcnt(0)" ::: "memory");
        } else {
            XB_SPIN(xb_ld(&bar[XB_XGEN(b.x)]) == gen, bar);
            __builtin_amdgcn_fence(__ATOMIC_ACQUIRE, "agent");
            asm volatile("s_waitcnt vmcnt(0)" ::: "memory");
        }
    }
    __syncthreads();
}

constexpr int NWAVES = 8;
#ifndef MK_N_LAUNCHES
#define MK_N_LAUNCHES 1
#endif
constexpr int N_LAUNCHES = MK_N_LAUNCHES;
constexpr int N_PHASES = 7;
#ifndef PROBE_REP_PHASE
#define PROBE_REP_PHASE -1
#endif
#define NREP(k) ((PROBE_REP_PHASE == (k)) ? 2 : 1)
constexpr int BATCH = 16, SEQ = 2048, D = 1024, M = BATCH * SEQ;
constexpr int GH = 4, GDK = 64, GDV = 128, CHUNK = 64, RANK = 16, CONVW = 512, FF = 2816;
constexpr int IN_COLS = 3088;
constexpr int SRC_A = 1536, SRC_CB = 1552;
constexpr int NP = 3328;
constexpr int PC_Q = 0, PC_K = 256, PC_V = 512, PC_G = 1024, PC_GATE = 1536, PC_CB = 1792, PC_CC = 2304, PC_CH = 2816;
constexpr int NGU = 2 * FF;
constexpr float EPS = 1e-6f;

constexpr size_t MiB = 1u << 20;
constexpr size_t WS_CTL = 0, CTL_ZERO_BYTES = 1 * MiB;
constexpr size_t WS_WIN = 2 * MiB, WS_WOUT = 10 * MiB, WS_WGU = 12 * MiB, WS_WDN = 24 * MiB;
constexpr size_t WS_SSQ1 = 30 * MiB, WS_SSQ2 = 32 * MiB;
constexpr size_t WS_XN = 64 * MiB;
constexpr size_t WS_PROJ = 128 * MiB;
constexpr size_t WS_MIX = 336 * MiB;
constexpr size_t WS_END = 400 * MiB;
static_assert(WS_WIN + (size_t)NP * D * 2 <= WS_WOUT && WS_WOUT + (size_t)D * D * 2 <= WS_WGU && WS_WGU + (size_t)NGU * D * 2 <= WS_WDN && WS_WDN + (size_t)D * FF * 2 <= WS_SSQ1, "weights");
static_assert(WS_SSQ1 + (size_t)M * 16 * 4 <= WS_SSQ2 && WS_SSQ2 + (size_t)M * 16 * 4 <= WS_XN && WS_XN + (size_t)M * D * 2 <= WS_PROJ && WS_PROJ + (size_t)M * NP * 2 <= WS_MIX && WS_PROJ + (size_t)M * FF * 2 <= WS_MIX && WS_MIX + (size_t)M * D * 2 <= WS_END, "d_ws map");
constexpr int CW_BAR = 4096;

constexpr int RING_OFF = 0, RING_BYTES = 131072;
constexpr int LDSCTL_OFF = RING_BYTES, MISC_OFF = LDSCTL_OFF + 320;
constexpr int LDS_BYTES = 147456;
static_assert(MISC_OFF + 128 <= LDS_BYTES, "LDS map");

__device__ __forceinline__ float wave_sum(float v) {
#pragma unroll
    for (int o = 1; o < 64; o <<= 1) v += __shfl_xor(v, o);
    return v;
}
__device__ __forceinline__ float bf_lo(unsigned w) { return __builtin_bit_cast(float, w << 16); }
__device__ __forceinline__ float bf_hi(unsigned w) { return __builtin_bit_cast(float, w & 0xffff0000u); }

__device__ __forceinline__ void p0_transpose_item(const float* W, int ld, int K, bf16* WT, int row_off, int kb, int nb, const float* kscale, float scale, LAS float* scr, int lane) {
    const int k0 = 64 * kb, n0 = 32 * nb;
#pragma unroll 8
    for (int i = 0; i < 32; ++i) { const int kk = 2 * i + (lane >> 5); float v = W[(size_t)(k0 + kk) * ld + n0 + (lane & 31)] * scale; if (kscale) v *= kscale[k0 + kk]; scr[kk * 33 + (lane & 31)] = v; }
    LDS_WAIT(); asm volatile("" ::: "memory");
    const int c = lane & 7;
#pragma unroll
    for (int j = 0; j < 4; ++j) { const int n = (lane >> 3) + 8 * j; const LAS float* s = scr + (8 * c) * 33 + n;
        v4u o; o.x = pk2(s[0 * 33], s[1 * 33]); o.y = pk2(s[2 * 33], s[3 * 33]); o.z = pk2(s[4 * 33], s[5 * 33]); o.w = pk2(s[6 * 33], s[7 * 33]);
        *(GAS v4u*)(WT + (size_t)(row_off + n0 + n) * K + k0 + 8 * c) = o; }
    LDS_WAIT(); asm volatile("" ::: "memory");
}
__device__ __forceinline__ void p0_gate_item(const float* w_in, const float* wgu, bf16* WT, int kb, int jb, int lane) {
    const int k = 64 * kb + lane; float a[RANK];
#pragma unroll
    for (int r = 0; r < RANK; ++r) a[r] = w_in[(size_t)k * IN_COLS + SRC_A + r];
#pragma unroll
    for (int jj = 0; jj < 8; ++jj) { const int j = 8 * jb + jj; float s = 0.f;
#pragma unroll
        for (int r = 0; r < RANK; ++r) s += a[r] * wgu[r * 256 + j];
        WT[(size_t)(PC_GATE + j) * D + k] = (bf16)f2bf(s); }
}
__device__ __forceinline__ void rms_row_to_bf16(const float* xrow, const float* g, bf16* orow, int lane) {
    const GAS f32x4* xr = (const GAS f32x4*)xrow + lane; const GAS f32x4* gr = (const GAS f32x4*)g + lane;
    f32x4 v[4]; float s = 0.f;
#pragma unroll
    for (int j = 0; j < 4; ++j) { v[j] = xr[64 * j]; s += (v[j].x * v[j].x + v[j].y * v[j].y) + (v[j].z * v[j].z + v[j].w * v[j].w); }
    const float rstd = rsqrtf(wave_sum(s) * (1.f / D) + EPS);
    GAS unsigned long long* o8 = (GAS unsigned long long*)orow + lane;
#pragma unroll
    for (int j = 0; j < 4; ++j) { const f32x4 gg = gr[64 * j]; o8[64 * j] = (unsigned long long)pk2(v[j].x * rstd * gg.x, v[j].y * rstd * gg.y) | ((unsigned long long)pk2(v[j].z * rstd * gg.z, v[j].w * rstd * gg.w) << 32); }
}

typedef short v4i16_t __attribute__((ext_vector_type(4)));
typedef float f32x2_t __attribute__((ext_vector_type(2))); typedef __bf16 bf16x2_t __attribute__((ext_vector_type(2)));
typedef unsigned v2u __attribute__((ext_vector_type(2)));
__device__ __forceinline__ unsigned cvtpk_s(float lo, float hi) { f32x2_t v = {lo, hi}; bf16x2_t b = __builtin_convertvector(v, bf16x2_t); return __builtin_bit_cast(unsigned, b); }
__device__ __forceinline__ v4i16_t ds_tr(const LAS unsigned char* p) { return __builtin_amdgcn_ds_read_tr16_b64_v4i16((LAS v4i16_t*)p); }
__device__ __forceinline__ bf16x8 pack8(f32x4 lo, f32x4 hi) { v4u w; w.x = cvtpk_s(lo[0], lo[1]); w.y = cvtpk_s(lo[2], lo[3]); w.z = cvtpk_s(hi[0], hi[1]); w.w = cvtpk_s(hi[2], hi[3]); return __builtin_bit_cast(bf16x8, w); }
__device__ __forceinline__ f32x4 mfma16(bf16x8 a, bf16x8 b, f32x4 c) { return __builtin_amdgcn_mfma_f32_16x16x32_bf16(a, b, c, 0, 0, 0); }
constexpr int GQ_STR = 144, GS_STR = 160, GV_STR = 288, GO_STR = 132;
constexpr int GL_QI = 0, GL_KI = GL_QI + 64 * GQ_STR, GL_KS = GL_KI + 64 * GQ_STR, GL_V = GL_KS + 64 * GS_STR, GL_O = GL_V + 64 * GV_STR, GL_WT = GL_O + 64 * GO_STR * 4, GL_DEC = GL_WT + 8 * 64 * 4, GL_END = GL_DEC + 256;
static_assert(GL_END <= RING_BYTES && GL_KI % 16 == 0 && GL_KS % 16 == 0 && GL_V % 16 == 0 && GL_O % 16 == 0 && GL_WT % 16 == 0 && GL_DEC % 16 == 0, "GLA LDS map");
#define GLA_LOADS(n_, Z, Q, K, V0, V1, G0, G1) do { const bf16* pr_ = PROJ + (rowbase + (size_t)(n_) * CHUNK + t) * NP; \
    Z = *(const GAS v4u*)(pr_ + PC_GATE + h * 64 + c8); Q = *(const GAS v4u*)(pr_ + PC_Q + h * 64 + c8); K = *(const GAS v4u*)(pr_ + PC_K + h * 64 + c8); \
    V0 = *(const GAS v4u*)(pr_ + PC_V + h * 128 + c8); V1 = *(const GAS v4u*)(pr_ + PC_V + h * 128 + 64 + c8); \
    G0 = *(const GAS v4u*)(pr_ + PC_G + h * 128 + 2 * c8); G1 = *(const GAS v4u*)(pr_ + PC_G + h * 128 + 2 * c8 + 8); } while (0)
__device__ __forceinline__ void gla_unit(LAS unsigned char* lds, const bf16* PROJ, bf16* MIX, const float* b_gate, const float* gla_g, int b, int h, int tid, int lane, int wave) {
    const int tl = lane & 7, cg = lane >> 3, t = 8 * wave + tl, c8 = cg * 8;
    const float m1 = tl >= 1 ? 1.f : 0.f, m2 = tl >= 2 ? 1.f : 0.f, m4 = tl >= 4 ? 1.f : 0.f;
    const int fr = lane & 15, fq = lane >> 4, trq = fr >> 2, trp = fr & 3;
    const size_t rowbase = (size_t)b * SEQ;
    float bg[8], gg[16];
#pragma unroll
    for (int e = 0; e < 8; ++e) bg[e] = b_gate[h * 64 + c8 + e];
#pragma unroll
    for (int e = 0; e < 16; ++e) gg[e] = gla_g[2 * c8 + e];
    f32x4 Sacc[4];
#pragma unroll
    for (int m = 0; m < 4; ++m) Sacc[m] = (f32x4){0.f, 0.f, 0.f, 0.f};
    LAS float* Lo = (LAS float*)(lds + GL_O);
    v4u cz, cq, ck, cv0, cv1, cg0, cg1;
    GLA_LOADS(0, cz, cq, ck, cv0, cv1, cg0, cg1);
    for (int n = 0; n < SEQ / CHUNK; ++n) {
        float cs[8];
        { const unsigned zw[4] = {cz.x, cz.y, cz.z, cz.w};
#pragma unroll
          for (int e = 0; e < 4; ++e) { const float z0 = bf_lo(zw[e]) + bg[2 * e], z1 = bf_hi(zw[e]) + bg[2 * e + 1];
              cs[2 * e]     = fminf(z0, 0.f) * (1.44269504089f / 16.f) - __builtin_amdgcn_logf(1.f + __builtin_amdgcn_exp2f(-1.44269504089f * fabsf(z0))) * (1.f / 16.f);
              cs[2 * e + 1] = fminf(z1, 0.f) * (1.44269504089f / 16.f) - __builtin_amdgcn_logf(1.f + __builtin_amdgcn_exp2f(-1.44269504089f * fabsf(z1))) * (1.f / 16.f); } }
#pragma unroll
        for (int e = 0; e < 8; ++e) {
            cs[e] += m1 * __builtin_bit_cast(float, __builtin_amdgcn_update_dpp(0, __builtin_bit_cast(int, cs[e]), 0x111, 0xf, 0xf, true));
            cs[e] += m2 * __builtin_bit_cast(float, __builtin_amdgcn_update_dpp(0, __builtin_bit_cast(int, cs[e]), 0x112, 0xf, 0xf, true));
            cs[e] += m4 * __builtin_bit_cast(float, __builtin_amdgcn_update_dpp(0, __builtin_bit_cast(int, cs[e]), 0x114, 0xf, 0xf, true));
        }
        if (tl == 7) { *(LAS f32x4*)(lds + GL_WT + (wave * 64 + c8) * 4) = (f32x4){cs[0], cs[1], cs[2], cs[3]}; *(LAS f32x4*)(lds + GL_WT + (wave * 64 + c8 + 4) * 4) = (f32x4){cs[4], cs[5], cs[6], cs[7]}; }
        LDS_WAIT(); __syncthreads();
        {
            float off8[8], tot[8];
#pragma unroll
            for (int e = 0; e < 8; ++e) { off8[e] = 0.f; tot[e] = 0.f; }
#pragma unroll
            for (int w = 0; w < 8; ++w) { const float mw = (w < wave) ? 1.f : 0.f; const f32x4 a0 = *(const LAS f32x4*)(lds + GL_WT + (w * 64 + c8) * 4), a1 = *(const LAS f32x4*)(lds + GL_WT + (w * 64 + c8 + 4) * 4);
#pragma unroll
                for (int e = 0; e < 4; ++e) { tot[e] += a0[e]; tot[4 + e] += a1[e]; off8[e] += mw * a0[e]; off8[4 + e] += mw * a1[e]; } }
            const unsigned qw[4] = {cq.x, cq.y, cq.z, cq.w}, kw[4] = {ck.x, ck.y, ck.z, ck.w};
            float et[8];
#pragma unroll
            for (int e = 0; e < 8; ++e) et[e] = __builtin_amdgcn_exp2f(tot[e]);
            unsigned qo[4], ko[4], so[4];
#pragma unroll
            for (int e = 0; e < 4; ++e) {
                const float b0 = off8[2 * e] + cs[2 * e], b1 = off8[2 * e + 1] + cs[2 * e + 1];
                const float q0 = bf_lo(qw[e]), q1 = bf_hi(qw[e]);
                const float ki0 = bf_lo(kw[e]) * __builtin_amdgcn_exp2f(-b0), ki1 = bf_hi(kw[e]) * __builtin_amdgcn_exp2f(-b1);
                qo[e] = cvtpk_s(q0 * __builtin_amdgcn_exp2f(b0), q1 * __builtin_amdgcn_exp2f(b1));
                ko[e] = cvtpk_s(ki0, ki1);
                so[e] = cvtpk_s(ki0 * et[2 * e], ki1 * et[2 * e + 1]);
            }
            *(LAS v4u*)(lds + GL_QI + t * GQ_STR + c8 * 2) = (v4u){qo[0], qo[1], qo[2], qo[3]};
            *(LAS v4u*)(lds + GL_KI + t * GQ_STR + c8 * 2) = (v4u){ko[0], ko[1], ko[2], ko[3]};
            *(LAS v4u*)(lds + GL_KS + t * GS_STR + c8 * 2) = (v4u){so[0], so[1], so[2], so[3]};
            *(LAS v4u*)(lds + GL_V + t * GV_STR + c8 * 2) = cv0; *(LAS v4u*)(lds + GL_V + t * GV_STR + 128 + c8 * 2) = cv1;
            if (t == 63) { *(LAS f32x4*)(lds + GL_DEC + c8 * 4) = (f32x4){et[0], et[1], et[2], et[3]}; *(LAS f32x4*)(lds + GL_DEC + (c8 + 4) * 4) = (f32x4){et[4], et[5], et[6], et[7]}; }
        }
        const v4u pg0 = cg0, pg1 = cg1;
        { const int nn = (n + 1 < SEQ / CHUNK) ? n + 1 : n; GLA_LOADS(nn, cz, cq, ck, cv0, cv1, cg0, cg1); }
        LDS_WAIT(); __syncthreads();
        {
            bf16x8 Qf[4][2], Kf[4][2];
#pragma unroll
            for (int nt = 0; nt < 4; ++nt)
#pragma unroll
                for (int s = 0; s < 2; ++s) {
                    const LAS unsigned char* pq = lds + GL_QI + (16 * nt + fr) * GQ_STR + (32 * s + 4 * fq) * 2; const LAS unsigned char* pk = lds + GL_KI + (16 * nt + fr) * GQ_STR + (32 * s + 4 * fq) * 2;
                    const v2u ql = *(const LAS v2u*)pq, qh = *(const LAS v2u*)(pq + 32), kl = *(const LAS v2u*)pk, kh = *(const LAS v2u*)(pk + 32);
                    Qf[nt][s] = __builtin_bit_cast(bf16x8, (v4u){ql.x, ql.y, qh.x, qh.y}); Kf[nt][s] = __builtin_bit_cast(bf16x8, (v4u){kl.x, kl.y, kh.x, kh.y});
                }
            bf16x8 Vf[2];
#pragma unroll
            for (int s = 0; s < 2; ++s) { const LAS unsigned char* p = lds + GL_V + (32 * s + 4 * fq + trq) * GV_STR + (16 * wave + 4 * trp) * 2;
                const v4i16_t a = ds_tr(p), c = ds_tr(p + 16 * GV_STR); Vf[s] = (bf16x8){a[0], a[1], a[2], a[3], c[0], c[1], c[2], c[3]}; }
            f32x4 Oacc[4];
            const f32x4 zero4 = (f32x4){0.f, 0.f, 0.f, 0.f};
#pragma unroll
            for (int nt = 0; nt < 4; ++nt) {
                f32x4 sc[4];
#pragma unroll
                for (int mt = 0; mt < 4; ++mt) {
                    if (mt > nt) { sc[mt] = zero4; continue; }
                    f32x4 a = zero4;
#pragma unroll
                    for (int s = 0; s < 2; ++s) a = mfma16(Kf[mt][s], Qf[nt][s], a);
                    if (mt == nt) {
#pragma unroll
                        for (int r = 0; r < 4; ++r) if (4 * fq + r > fr) a[r] = 0.f;
                    }
                    sc[mt] = a;
                }
                f32x4 o = zero4;
                o = mfma16(pack8(sc[0], sc[1]), Vf[0], o);
                if (nt >= 2) o = mfma16(pack8(sc[2], sc[3]), Vf[1], o);
                Oacc[nt] = o;
            }
            {
                bf16x8 Sf[2];
#pragma unroll
                for (int s = 0; s < 2; ++s) Sf[s] = pack8(Sacc[2 * s], Sacc[2 * s + 1]);
#pragma unroll
                for (int nt = 0; nt < 4; ++nt)
#pragma unroll
                    for (int s = 0; s < 2; ++s) Oacc[nt] = mfma16(Qf[nt][s], Sf[s], Oacc[nt]);
            }
#pragma unroll
            for (int nt = 0; nt < 4; ++nt)
#pragma unroll
                for (int r = 0; r < 4; ++r) Lo[(16 * nt + 4 * fq + r) * GO_STR + 16 * wave + fr] = Oacc[nt][r];
#pragma unroll
            for (int m = 0; m < 4; ++m) { const f32x4 d = *(const LAS f32x4*)(lds + GL_DEC + (16 * m + 4 * fq) * 4); f32x4 sa = Sacc[m] * d;
#pragma unroll
                for (int s = 0; s < 2; ++s) { const LAS unsigned char* p = lds + GL_KS + (32 * s + 4 * fq + trq) * GS_STR + (16 * m + 4 * trp) * 2;
                    const v4i16_t a = ds_tr(p), c = ds_tr(p + 16 * GS_STR); const bf16x8 Af = (bf16x8){a[0], a[1], a[2], a[3], c[0], c[1], c[2], c[3]};
                    sa = mfma16(Af, Vf[s], sa); }
                Sacc[m] = sa; }
        }
        LDS_WAIT(); __syncthreads();
        {
            float ov[16]; float s = 0.f;
#pragma unroll
            for (int i4 = 0; i4 < 4; ++i4) { const f32x4 o4 = *(const LAS f32x4*)(Lo + t * GO_STR + 16 * cg + 4 * i4);
#pragma unroll
                for (int e = 0; e < 4; ++e) { ov[4 * i4 + e] = o4[e]; s += o4[e] * o4[e]; } }
            s += __shfl_xor(s, 8); s += __shfl_xor(s, 16); s += __shfl_xor(s, 32);
            const float rstd = rsqrtf(s * (1.f / GDV) + EPS);
            const unsigned gw_[8] = {pg0.x, pg0.y, pg0.z, pg0.w, pg1.x, pg1.y, pg1.z, pg1.w};
            unsigned ow[8];
#pragma unroll
            for (int e = 0; e < 8; ++e) ow[e] = cvtpk_s(ov[2 * e] * rstd * gg[2 * e] * pg8::fast_silu(bf_lo(gw_[e])), ov[2 * e + 1] * rstd * gg[2 * e + 1] * pg8::fast_silu(bf_hi(gw_[e])));
            bf16* po = MIX + (rowbase + (size_t)n * CHUNK + t) * D + h * 128 + 16 * cg;
            *(GAS v4u*)po = (v4u){ow[0], ow[1], ow[2], ow[3]}; *(GAS v4u*)(po + 8) = (v4u){ow[4], ow[5], ow[6], ow[7]};
        }
    }
    __syncthreads();
}

struct Args { const float* in[13]; float* out; unsigned char* ws; int ph_lo, ph_hi; };
static_assert(sizeof(Args) == 13 * 8 + 8 + 8 + 8, "Args has no padding");

__global__ void __launch_bounds__(NWAVES * 64, 2) hymba_fwd(Args args) {
    extern __shared__ __attribute__((aligned(16))) unsigned char lds_raw[];
    LAS unsigned char* lds = (LAS unsigned char*)lds_raw;
    volatile LAS unsigned* MISC = (volatile LAS unsigned*)(lds + MISC_OFF);
    const int tid = threadIdx.x, lane = tid & 63, wave = __builtin_amdgcn_readfirstlane(tid >> 6);
    const int G = gridDim.x, bx = blockIdx.x;
    const int vcu = (G % 8 == 0) ? (bx % 8) * (G / 8) + bx / 8 : bx;
    unsigned char* ws = args.ws;
    gu32* ctl = (gu32*)(ws + WS_CTL);
    const float* x = args.in[0]; const float* norm1_g = args.in[1]; const float* w_in = args.in[2]; const float* w_gate_up = args.in[3]; const float* b_gate = args.in[4];
    const float* gla_g = args.in[5]; const float* conv_w = args.in[6]; const float* w_out = args.in[7]; const float* norm2_g = args.in[8];
    const float* w_fg = args.in[9]; const float* w_fu = args.in[10]; const float* w_fd = args.in[11]; const float* normf_g = args.in[12];
    float* out = args.out;
    bf16* WIN = (bf16*)(ws + WS_WIN); bf16* WOUT = (bf16*)(ws + WS_WOUT); bf16* WGU = (bf16*)(ws + WS_WGU); bf16* WDN = (bf16*)(ws + WS_WDN);
    float* SSQ1 = (float*)(ws + WS_SSQ1); float* SSQ2 = (float*)(ws + WS_SSQ2);
    bf16* XN = (bf16*)(ws + WS_XN); bf16* PROJ = (bf16*)(ws + WS_PROJ); bf16* HID = (bf16*)(ws + WS_PROJ); bf16* MIX = (bf16*)(ws + WS_MIX);

    for (int u = tid; u < (LDS_BYTES - LDSCTL_OFF) / 4; u += NWAVES * 64) ((LAS unsigned*)(lds + LDSCTL_OFF))[u] = 0u;
    __syncthreads();
    XcdBarrier bar; bar.bar = (unsigned*)(ctl + CW_BAR); bar.x = 0; bar.st = nullptr;
    if (N_LAUNCHES == 1) bar = xcd_barrier_post((unsigned*)(ctl + CW_BAR), MISC + 8);
#define GRID_BAR() do { if (N_LAUNCHES == 1) xcd_barrier(bar); } while (0)
    const int lo = args.ph_lo, hi = args.ph_hi;
#define IN(k) (lo <= (k) && (k) < hi)
#define BOTH(k) (IN(k) && IN((k) + 1))
    const int gw = vcu * NWAVES + wave, NGW = G * NWAVES;

    if (IN(0)) { for (int rep_ = 0; rep_ < NREP(0); ++rep_) {
        LAS float* scr = (LAS float*)(lds + RING_OFF + wave * 16384);
        constexpr int I_IN1 = 16 * 48, I_IN2 = 16 * 48, I_GATE = 16 * 32, I_OUT = 16 * 32, I_FG = 16 * 88, I_FU = 16 * 88, I_FD = 44 * 32;
        constexpr int NITEMS = I_IN1 + I_IN2 + I_GATE + I_OUT + I_FG + I_FU + I_FD;
        for (int it = gw; it < NITEMS; it += NGW) {
            int r = it;
            if (r < I_IN1) { const int kb = r / 48, nb = r % 48; p0_transpose_item(w_in, IN_COLS, D, WIN, 0, kb, nb, nullptr, nb < 8 ? 0.125f : 1.0f, scr, lane); continue; } r -= I_IN1;
            if (r < I_IN2) { const int kb = r / 48, nb = r % 48; p0_transpose_item(w_in + SRC_CB, IN_COLS, D, WIN, PC_CB, kb, nb, nullptr, 1.0f, scr, lane); continue; } r -= I_IN2;
            if (r < I_GATE) { p0_gate_item(w_in, w_gate_up, WIN, r / 32, r % 32, lane); continue; } r -= I_GATE;
            if (r < I_OUT) { p0_transpose_item(w_out, D, D, WOUT, 0, r / 32, r % 32, nullptr, 1.0f, scr, lane); continue; } r -= I_OUT;
            if (r < I_FG) { const int kb = r / 88, nb = r % 88, n0 = 32 * nb; p0_transpose_item(w_fg, FF, D, WGU, 256 * (n0 / 128) + (n0 % 128) - n0, kb, nb, norm2_g, 1.0f, scr, lane); continue; } r -= I_FG;
            if (r < I_FU) { const int kb = r / 88, nb = r % 88, n0 = 32 * nb; p0_transpose_item(w_fu, FF, D, WGU, 256 * (n0 / 128) + 128 + (n0 % 128) - n0, kb, nb, norm2_g, 1.0f, scr, lane); continue; } r -= I_FU;
            p0_transpose_item(w_fd, D, FF, WDN, 0, r / 32, r % 32, nullptr, 1.0f, scr, lane);
        }
        for (int m = gw; m < M; m += NGW) rms_row_to_bf16(x + (size_t)m * D, norm1_g, XN + (size_t)m * D, lane);
        }
        if (BOTH(0)) GRID_BAR();
    }

    if (IN(1)) {
        pg8::Gemm g{XN, WIN, M, NP, D}; pg8::StaticOrder S; S.init(M, NP, G, bx);
        pg8::EpiStoreBf16 E{PROJ, NP};
        for (int rep_ = 0; rep_ < NREP(1); ++rep_) pg8::gemm_phase<pg8::EpiStoreBf16, pg8::StaticOrder, PG8_ALIGN, PG8_SP2>(lds + RING_OFF, g, S, E);
        if (BOTH(1)) GRID_BAR();
    }

    if (IN(2)) {
        const bool do_gla = (G <= 64) || (bx < 64), do_conv = (G <= 64) || (bx >= 64);
        for (int rep_ = 0; rep_ < NREP(2); ++rep_) {
        if (do_gla) for (int unit = bx; unit < BATCH * GH; unit += G) gla_unit(lds + RING_OFF, PROJ, MIX, b_gate, gla_g, unit >> 2, unit & 3, tid, lane, wave);
        if (do_conv) {
            const int ncw = ((G <= 64) ? G : G - 64) * NWAVES, cw = ((G <= 64) ? bx : bx - 64) * NWAVES + wave;
            const int c0 = lane * 8;
            float w0[8], w1[8], w2[8];
#pragma unroll
            for (int e = 0; e < 8; ++e) { w0[e] = conv_w[c0 + e]; w1[e] = conv_w[CONVW + c0 + e]; w2[e] = conv_w[2 * CONVW + c0 + e]; }
            for (int item = cw; item < M / 8; item += ncw) {
                const int m0 = item * 8, s0 = m0 % SEQ;
                float um2[8], um1[8];
#pragma unroll
                for (int e = 0; e < 8; ++e) { um2[e] = 0.f; um1[e] = 0.f; }
                if (s0 > 0) {
#pragma unroll
                    for (int back = 2; back >= 1; --back) { const bf16* pr = PROJ + (size_t)(m0 - back) * NP;
                        const v4u cc = *(const GAS v4u*)(pr + PC_CC + c0), ch = *(const GAS v4u*)(pr + PC_CH + c0);
                        const unsigned ca[4] = {cc.x, cc.y, cc.z, cc.w}, ha[4] = {ch.x, ch.y, ch.z, ch.w};
#pragma unroll
                        for (int e = 0; e < 4; ++e) { const float u0 = bf_lo(ca[e]) * bf_lo(ha[e]), u1 = bf_hi(ca[e]) * bf_hi(ha[e]);
                            if (back == 2) { um2[2 * e] = u0; um2[2 * e + 1] = u1; } else { um1[2 * e] = u0; um1[2 * e + 1] = u1; } } }
                }
#pragma unroll
                for (int rr = 0; rr < 8; ++rr) { const bf16* pr = PROJ + (size_t)(m0 + rr) * NP;
                    const v4u cb = *(const GAS v4u*)(pr + PC_CB + c0), cc = *(const GAS v4u*)(pr + PC_CC + c0), ch = *(const GAS v4u*)(pr + PC_CH + c0);
                    const unsigned ba[4] = {cb.x, cb.y, cb.z, cb.w}, ca[4] = {cc.x, cc.y, cc.z, cc.w}, ha[4] = {ch.x, ch.y, ch.z, ch.w};
                    unsigned ow[4];
#pragma unroll
                    for (int e = 0; e < 4; ++e) { const float u0 = bf_lo(ca[e]) * bf_lo(ha[e]), u1 = bf_hi(ca[e]) * bf_hi(ha[e]);
                        const float y0 = w0[2 * e] * um2[2 * e] + w1[2 * e] * um1[2 * e] + w2[2 * e] * u0, y1 = w0[2 * e + 1] * um2[2 * e + 1] + w1[2 * e + 1] * um1[2 * e + 1] + w2[2 * e + 1] * u1;
                        ow[e] = pk2(bf_lo(ba[e]) * y0, bf_hi(ba[e]) * y1);
                        um2[2 * e] = um1[2 * e]; um2[2 * e + 1] = um1[2 * e + 1]; um1[2 * e] = u0; um1[2 * e + 1] = u1; }
                    *(GAS v4u*)(MIX + (size_t)(m0 + rr) * D + CONVW + c0) = (v4u){ow[0], ow[1], ow[2], ow[3]}; }
            }
        }
        }
        if (BOTH(2)) GRID_BAR();
    }

    if (IN(3)) {
        pg8::Gemm g{MIX, WOUT, M, D, D}; pg8::StaticOrder S; S.init(M, D, G, bx);
        pg8::EpiResid<false, false, true> E{x, nullptr, nullptr, XN, SSQ1, D};
        for (int rep_ = 0; rep_ < NREP(3); ++rep_) pg8::gemm_phase<pg8::EpiResid<false, false, true>, pg8::StaticOrder, PG8_ALIGN, PG8_SP2>(lds + RING_OFF, g, S, E);
        if (BOTH(3)) GRID_BAR();
    }

    if (IN(4)) {
        pg8::Gemm g{XN, WGU, M, NGU, D}; pg8::StaticOrder S; S.init(M, NGU, G, bx);
        pg8::EpiSwiglu E{HID, FF, SSQ1, 1.f / D, EPS};
        for (int rep_ = 0; rep_ < NREP(4); ++rep_) pg8::gemm_phase<pg8::EpiSwiglu, pg8::StaticOrder, PG8_ALIGN, PG8_SP2>(lds + RING_OFF, g, S, E);
        if (BOTH(4)) GRID_BAR();
    }

    if (IN(5)) {
        pg8::Gemm g{HID, WDN, M, D, FF}; pg8::StaticOrder S; S.init(M, D, G, bx);
        pg8::EpiResid<true, true, false> E{nullptr, XN, out, nullptr, SSQ2, D};
        pg8::gemm_phase<pg8::EpiResid<true, true, false>, pg8::StaticOrder, PG8_ALIGN, PG8_SP2>(lds + RING_OFF, g, S, E);
        if (BOTH(5)) GRID_BAR();
    }

    if (IN(6)) {
        for (int m = gw; m < M; m += NGW) {
            const GAS f32x4* p = (const GAS f32x4*)(SSQ2 + (size_t)m * 16); const f32x4 a = p[0], b = p[1], c = p[2], d = p[3];
            const f32x4 t = (a + b) + (c + d); const float rstd = rsqrtf(((t[0] + t[1]) + (t[2] + t[3])) * (1.f / D) + EPS);
            GAS f32x4* xr = (GAS f32x4*)(out + (size_t)m * D) + lane; const GAS f32x4* gr = (const GAS f32x4*)normf_g + lane;
#pragma unroll
            for (int j = 0; j < 4; ++j) { const f32x4 v = xr[64 * j], gg = gr[64 * j]; xr[64 * j] = v * rstd * gg; }
        }
    }
#undef IN
#undef BOTH
}

extern "C" void kernel_launch(void* const* d_in, const int* in_sizes, int n_in, void* d_out, int out_size, void* d_ws, size_t ws_size, hipStream_t stream) {
    static int grid = 0;
    if (grid == 0) {
        if (n_in != 13 || in_sizes[0] != M * D || out_size != M * D || ws_size < WS_END) { fprintf(stderr, "kernel_launch: unexpected shapes (n_in %d, in0 %d, out %d, ws %zu); nothing launched\n", n_in, n_in > 0 ? in_sizes[0] : -1, out_size, ws_size); grid = -1; return; }
        int dev = 0, cus = 0, per_cu = 0;
        if (hipGetDevice(&dev) != hipSuccess || hipDeviceGetAttribute(&cus, hipDeviceAttributeMultiprocessorCount, dev) != hipSuccess) { fprintf(stderr, "kernel_launch: device query failed\n"); grid = -1; return; }
        if (hipFuncSetAttribute((const void*)hymba_fwd, hipFuncAttributeMaxDynamicSharedMemorySize, LDS_BYTES) != hipSuccess) { fprintf(stderr, "kernel_launch: hipFuncSetAttribute failed\n"); grid = -1; return; }
        if (hipOccupancyMaxActiveBlocksPerMultiprocessor(&per_cu, (const void*)hymba_fwd, NWAVES * 64, LDS_BYTES) != hipSuccess || per_cu < 1)
            fprintf(stderr, "kernel_launch: note: occupancy query reports %d workgroups per CU\n", per_cu);
        (void)hipGetLastError();
        grid = cus;
    }
    if (grid < 0) return;
    if (hipMemsetAsync((char*)d_ws + WS_CTL, 0, CTL_ZERO_BYTES, stream) != hipSuccess) { fprintf(stderr, "kernel_launch: hipMemsetAsync failed\n"); return; }
    Args a{};
    for (int i = 0; i < 13; ++i) a.in[i] = (const float*)d_in[i];
    a.out = (float*)d_out; a.ws = (unsigned char*)d_ws;
    for (int li = 0; li < N_LAUNCHES; ++li) {
        a.ph_lo = (N_LAUNCHES == 1) ? 0 : li; a.ph_hi = (N_LAUNCHES == 1) ? N_PHASES : li + 1;
        hipLaunchKernelGGL(hymba_fwd, dim3(grid), dim3(NWAVES * 64), LDS_BYTES, stream, a);
        const hipError_t le = hipPeekAtLastError();
        if (le != hipSuccess) { fprintf(stderr, "kernel_launch: launch %d failed: %s\n", li, hipGetErrorName(le)); break; }
    }
}
```
